# Optimizing an MI355X kernel written in HIP

```python
import math
import jax
import jax.numpy as jnp
from jax import lax
import numpy as np

D_MODEL = 1024
BATCH = 8
SEQ = 2048
DEPTH = 4

HEAD_DIM = 64
QBLK = 128
RMS_EPS = 1e-6
NEG = -1e30
FORCE = 1e30

A_HEADS = 4
A_QK = HEAD_DIM // 2
A_V = HEAD_DIM
B_HEADS = 4
B_KV = 2
B_WINDOW = 128
C_HEADS = 8
C_KV = 2
CMP_LEN = 32
CMP_STRIDE = 16
CMP_HID = 128
SLC_LEN = 64
SLC_TOPN = 8
SLC_QBLK = 64
C_WINDOW = 512

A_W = A_HEADS * A_V
B_W = B_HEADS * HEAD_DIM
C_W = C_HEADS * HEAD_DIM
D_MIX = A_W + B_W + C_W
KV_B = B_KV * HEAD_DIM
KV_C = C_KV * HEAD_DIM
N_GATES = 3 * C_HEADS
SPLIT_SIZES = (A_W, A_W, A_W, A_W, B_W, KV_B, KV_B, B_W, C_W, KV_C, KV_C, KV_C, KV_C, KV_C, KV_C, N_GATES, C_W)
IN_COLS = 4 * A_W + 2 * B_W + 2 * KV_B + 2 * C_W + 6 * KV_C + N_GATES

kernel_name = 'hybrid_diffattn_swa_nsa_parallel_heads'


def rmsnorm(x, w):
    xf = x.astype(jnp.float32)
    y = xf * lax.rsqrt(jnp.mean(xf * xf, axis=-1, keepdims=True) + RMS_EPS)
    return (y * w.astype(jnp.float32)).astype(x.dtype)


def alibi_slopes(n):
    return jnp.asarray(2.0 ** (-8.0 * np.arange(1, n + 1) / n), dtype=jnp.float32)


def diff_attention(q1, q2, k1, k2, v, lam, slopes):
    b, s, h, dq = q1.shape
    nb = s // QBLK
    scale = dq ** -0.5
    kpos = jnp.arange(s)

    def one_block(args):
        qi, q1b, q2b = args
        t = qi * QBLK + jnp.arange(QBLK)
        dist = t[:, None] - kpos[None, :]
        valid = dist >= 0
        bias = -slopes[:, None, None] * dist.astype(jnp.float32)

        def probs(qb, kk):
            sc = jnp.einsum('bqhd,bkhd->bhqk', qb, kk).astype(jnp.float32) * scale + bias
            return jax.nn.softmax(jnp.where(valid, sc, NEG), axis=-1)

        a = probs(q1b, k1) - lam * probs(q2b, k2)
        return jnp.einsum('bhqk,bkhd->bqhd', a.astype(v.dtype), v)

    q1s = q1.reshape(b, nb, QBLK, h, dq).swapaxes(0, 1)
    q2s = q2.reshape(b, nb, QBLK, h, dq).swapaxes(0, 1)
    out = lax.map(one_block, (jnp.arange(nb), q1s, q2s))
    return out.swapaxes(0, 1).reshape(b, s, h, v.shape[-1])


def banded_attention(q, k, v, window, slopes, sinks=None):
    b, s, g, r, d = q.shape
    nb = s // QBLK
    npv = -(-window // QBLK)
    nk = (npv + 1) * QBLK

    def band(x):
        xp = jnp.pad(x, ((0, 0), (npv * QBLK, 0), (0, 0), (0, 0))).reshape(b, nb + npv, QBLK, g, d)
        return jnp.concatenate([xp[:, o:o + nb] for o in range(npv + 1)], axis=2)

    kb = band(k)
    vb = band(v)
    qb = q.reshape(b, nb, QBLK, g, r, d)
    sc = jnp.einsum('bnqgrd,bnkgd->bngrqk', qb, kb).astype(jnp.float32) * d ** -0.5
    qi = np.arange(QBLK)[:, None]
    kj = np.arange(nk)[None, :]
    dist = qi + npv * QBLK - kj
    kpos = np.arange(nb)[:, None, None] * QBLK - npv * QBLK + kj[None]
    valid = (dist[None] >= 0) & (dist[None] < window) & (kpos >= 0)
    sc = sc - slopes[:, :, None, None] * jnp.asarray(dist, dtype=jnp.float32)
    sc = jnp.where(valid[:, None, None], sc, NEG)
    if sinks is None:
        p = jax.nn.softmax(sc, axis=-1)
    else:
        sink = jnp.broadcast_to(sinks.astype(jnp.float32)[:, :, None, None], (b, nb, g, r, QBLK, 1))
        p = jax.nn.softmax(jnp.concatenate([sc, sink], axis=-1), axis=-1)[..., :nk]
    o = jnp.einsum('bngrqk,bnkgd->bnqgrd', p.astype(v.dtype), vb)
    return o.reshape(b, s, g, r, d)


def overlap_matrix(n_cmp, n_slc):
    cs = np.arange(n_cmp)[:, None] * CMP_STRIDE
    ss = np.arange(n_slc)[None, :] * SLC_LEN
    ov = np.minimum(cs + CMP_LEN, ss + SLC_LEN) - np.maximum(cs, ss)
    return jnp.asarray(np.maximum(ov, 0) / CMP_LEN, dtype=jnp.float32)


def compress(x, pe, w1, w2):
    b, s, g, d = x.shape
    nch = s // CMP_STRIDE
    ratio = CMP_LEN // CMP_STRIDE
    ncmp = nch - ratio + 1
    ch = x.reshape(b, nch, CMP_STRIDE, g, d)
    blocks = jnp.concatenate([ch[:, o:o + ncmp] for o in range(ratio)], axis=2)
    blocks = blocks + pe[:, None, :]
    flat = blocks.transpose(0, 1, 3, 2, 4).reshape(b, ncmp, g, CMP_LEN * d)
    return jax.nn.silu(flat @ w1) @ w2


def nsa_attention(q, kc, vc, ks, vs, kw, vw, gates, slopes, pe_k, pe_v, wk1, wk2, wv1, wv2):
    b, s, g, r, d = q.shape
    scale = d ** -0.5
    kcmp = compress(kc, pe_k, wk1, wk2)
    vcmp = compress(vc, pe_v, wv1, wv2)
    ncmp = kcmp.shape[1]
    t = jnp.arange(s)
    cend = jnp.arange(ncmp) * CMP_STRIDE + CMP_LEN - 1
    dist_c = t[:, None] - cend[None, :]
    valid_c = dist_c >= 0
    sc = jnp.einsum('bsgrd,bcgd->bgrsc', q, kcmp).astype(jnp.float32) * scale
    sc = sc - slopes[:, :, None, None] * dist_c.astype(jnp.float32)
    p_cmp = jax.nn.softmax(jnp.where(valid_c, sc, NEG), axis=-1) * valid_c
    o_cmp = jnp.einsum('bgrsc,bcgd->bsgrd', p_cmp.astype(vcmp.dtype), vcmp)
    n_slc = s // SLC_LEN
    topn = min(SLC_TOPN, n_slc)
    imp = jnp.einsum('bgrsc,cj->bsgj', p_cmp, overlap_matrix(ncmp, n_slc))
    blk = jnp.arange(n_slc)[None, :]
    cur = (t // SLC_LEN)[:, None]
    causal = blk * SLC_LEN <= t[:, None]
    forced = (blk == 0) | (blk == cur) | (blk == cur - 1)
    score = jnp.where(causal[:, None, :], jnp.where(forced[:, None, :], FORCE, imp), NEG)
    _, idx = lax.top_k(score, topn)
    ksb = ks.reshape(b, n_slc, SLC_LEN, g, d).transpose(0, 3, 1, 2, 4)
    vsb = vs.reshape(b, n_slc, SLC_LEN, g, d).transpose(0, 3, 1, 2, 4)
    nq = s // SLC_QBLK
    bi = jnp.arange(b)[:, None, None, None]
    gi = jnp.arange(g)[None, None, :, None]

    def one_block(args):
        qi, qb, ib = args
        kg = ksb[bi, gi, ib].reshape(b, SLC_QBLK, g, topn * SLC_LEN, d)
        vg = vsb[bi, gi, ib].reshape(b, SLC_QBLK, g, topn * SLC_LEN, d)
        tq = qi * SLC_QBLK + jnp.arange(SLC_QBLK)
        kpos = (ib[..., None] * SLC_LEN + jnp.arange(SLC_LEN)).reshape(b, SLC_QBLK, g, topn * SLC_LEN)
        dist = (tq[None, :, None, None] - kpos)[:, :, :, None, :]
        scs = jnp.einsum('bqgrd,bqgkd->bqgrk', qb, kg).astype(jnp.float32) * scale
        scs = scs - slopes[None, None, :, :, None] * dist.astype(jnp.float32)
        p = jax.nn.softmax(jnp.where(dist >= 0, scs, NEG), axis=-1)
        return jnp.einsum('bqgrk,bqgkd->bqgrd', p.astype(vg.dtype), vg)

    qs = q.reshape(b, nq, SLC_QBLK, g, r, d).swapaxes(0, 1)
    ids = idx.reshape(b, nq, SLC_QBLK, g, topn).swapaxes(0, 1)
    o_slc = lax.map(one_block, (jnp.arange(nq), qs, ids)).swapaxes(0, 1).reshape(b, s, g, r, d)
    o_win = banded_attention(q, kw, vw, C_WINDOW, slopes)
    return gates[..., 0:1] * o_cmp + gates[..., 1:2] * o_slc + gates[..., 2:3] * o_win


def hybrid_layer(x, layer_idx, norm_w, w_in, w_out, lq1, lk1, lq2, lk2, subln_w, sinks,
                 pe_k, pe_v, wk1, wk2, wv1, wv2):
    b, s, _ = x.shape
    h = rmsnorm(x, norm_w) @ w_in
    offsets = np.cumsum(SPLIT_SIZES)[:-1].tolist()
    (qa, ka, va, ga, qb, kb, vb, gb, qc, kc, vc, ks, vs, kw, vw, gl, gc) = jnp.split(h, offsets, axis=-1)
    lam_init = 0.8 - 0.6 * math.exp(-0.3 * layer_idx)
    lam = (jnp.exp(jnp.sum(lq1.astype(jnp.float32) * lk1.astype(jnp.float32)))
           - jnp.exp(jnp.sum(lq2.astype(jnp.float32) * lk2.astype(jnp.float32))) + lam_init)
    qa = qa.reshape(b, s, A_HEADS, 2, A_QK)
    ka = ka.reshape(b, s, A_HEADS, 2, A_QK)
    oa = diff_attention(qa[..., 0, :], qa[..., 1, :], ka[..., 0, :], ka[..., 1, :],
                        va.reshape(b, s, A_HEADS, A_V), lam, alibi_slopes(A_HEADS))
    oa = rmsnorm(oa, subln_w) * (1.0 - lam_init)
    ya = oa.reshape(b, s, A_W) * jax.nn.silu(ga)
    rb = B_HEADS // B_KV
    ob = banded_attention(qb.reshape(b, s, B_KV, rb, HEAD_DIM), kb.reshape(b, s, B_KV, HEAD_DIM),
                          vb.reshape(b, s, B_KV, HEAD_DIM), B_WINDOW,
                          alibi_slopes(B_HEADS).reshape(B_KV, rb), sinks.reshape(B_KV, rb))
    yb = ob.reshape(b, s, B_W) * jax.nn.silu(gb)
    rc = C_HEADS // C_KV
    kvs = (b, s, C_KV, HEAD_DIM)
    gates = jax.nn.sigmoid(gl.reshape(b, s, C_KV, rc, 3))
    oc = nsa_attention(qc.reshape(b, s, C_KV, rc, HEAD_DIM), kc.reshape(kvs), vc.reshape(kvs),
                       ks.reshape(kvs), vs.reshape(kvs), kw.reshape(kvs), vw.reshape(kvs), gates,
                       alibi_slopes(C_HEADS).reshape(C_KV, rc), pe_k, pe_v, wk1, wk2, wv1, wv2)
    yc = oc.reshape(b, s, C_W) * jax.nn.silu(gc)
    return x + jnp.concatenate([ya, yb, yc], axis=-1) @ w_out


def setup_inputs(seed: int = 0) -> dict:
    key = jax.random.key(seed)
    ks = jax.random.split(key, 17)
    f32 = jnp.float32
    nrm = lambda k, shape, sc: jax.random.normal(k, shape, dtype=f32) * sc
    return {
        'x': nrm(ks[0], (BATCH, SEQ, D_MODEL), 1.0),
        'norm_w': 1.0 + nrm(ks[1], (DEPTH, D_MODEL), 0.02),
        'w_in': nrm(ks[2], (DEPTH, D_MODEL, IN_COLS), D_MODEL ** -0.5),
        'w_out': nrm(ks[3], (DEPTH, D_MIX, D_MODEL), D_MIX ** -0.5),
        'diff_lq1': nrm(ks[4], (DEPTH, A_QK), 0.1),
        'diff_lk1': nrm(ks[5], (DEPTH, A_QK), 0.1),
        'diff_lq2': nrm(ks[6], (DEPTH, A_QK), 0.1),
        'diff_lk2': nrm(ks[7], (DEPTH, A_QK), 0.1),
        'diff_subln': 1.0 + nrm(ks[8], (DEPTH, A_V), 0.02),
        'sinks': nrm(ks[9], (DEPTH, B_HEADS), 1.0),
        'cmp_pe_k': nrm(ks[10], (DEPTH, CMP_LEN, HEAD_DIM), 0.1),
        'cmp_pe_v': nrm(ks[11], (DEPTH, CMP_LEN, HEAD_DIM), 0.1),
        'cmp_wk1': nrm(ks[12], (DEPTH, CMP_LEN * HEAD_DIM, CMP_HID), (CMP_LEN * HEAD_DIM) ** -0.5),
        'cmp_wk2': nrm(ks[13], (DEPTH, CMP_HID, HEAD_DIM), CMP_HID ** -0.5),
        'cmp_wv1': nrm(ks[14], (DEPTH, CMP_LEN * HEAD_DIM, CMP_HID), (CMP_LEN * HEAD_DIM) ** -0.5),
        'cmp_wv2': nrm(ks[15], (DEPTH, CMP_HID, HEAD_DIM), CMP_HID ** -0.5),
        'final_norm': 1.0 + nrm(ks[16], (D_MODEL,), 0.02),
    }


def reference(x, norm_w, w_in, w_out, diff_lq1, diff_lk1, diff_lq2, diff_lk2, diff_subln, sinks,
              cmp_pe_k, cmp_pe_v, cmp_wk1, cmp_wk2, cmp_wv1, cmp_wv2, final_norm):
    for l in range(DEPTH):
        x = hybrid_layer(x, l, norm_w[l], w_in[l], w_out[l], diff_lq1[l], diff_lk1[l], diff_lq2[l],
                         diff_lk2[l], diff_subln[l], sinks[l], cmp_pe_k[l], cmp_pe_v[l],
                         cmp_wk1[l], cmp_wk2[l], cmp_wv1[l], cmp_wv2[l])
    return rmsnorm(x, final_norm)
```

```cpp
#include <hip/hip_runtime.h>
#include <hip/hip_cooperative_groups.h>
#include <cstdio>
namespace cg = cooperative_groups;

#ifndef MULTI_LAUNCH
#define MULTI_LAUNCH 0
#endif

typedef unsigned short u16;
typedef __attribute__((ext_vector_type(8))) short bf16x8;
typedef __attribute__((ext_vector_type(4))) float f32x4;
typedef __attribute__((ext_vector_type(4))) unsigned u32x4;

constexpr int NBATCH = 8, SEQ = 2048, TOK = NBATCH * SEQ, DM = 1024, DEPTH = 4;
constexpr int INC = 3608;
constexpr int HS = 3712;
constexpr int NT_IN = HS / 128;
constexpr int VTC = 640;
constexpr float LOG2E = 1.4426950408889634f;
constexpr int NPH = 2 + 5 * DEPTH;

constexpr int C_QA = 0, C_KA = 256, C_VA = 512, C_GA = 768, C_QB = 1024, C_KB = 1280, C_VB = 1408, C_GB = 1536,
              C_QC = 1792, C_KC = 2304, C_VC = 2432, C_KS = 2560, C_VS = 2688, C_KW = 2816, C_VW = 2944,
              C_GL = 3072, C_GC = 3096;

struct Params {
  const float* x; const float* norm_w; const float* w_in; const float* w_out;
  const float* lq1; const float* lk1; const float* lq2; const float* lk2;
  const float* subln; const float* sinks; const float* pe_k; const float* pe_v;
  const float* wk1; const float* wk2; const float* wv1; const float* wv2; const float* final_norm;
  float* out;
  unsigned char* ws;
};


constexpr size_t AL(size_t v) { return (v + 255) & ~(size_t)255; }
constexpr size_t OFF_CTR = 0;
constexpr size_t OFF_LAM = 16384;
constexpr size_t OFF_WIN = OFF_LAM + 1024;
constexpr size_t OFF_WOUT = AL(OFF_WIN + (size_t)DEPTH * HS * DM * 2);
constexpr size_t OFF_WK1 = AL(OFF_WOUT + (size_t)DEPTH * DM * DM * 2);
constexpr size_t OFF_WV1 = AL(OFF_WK1 + (size_t)DEPTH * 128 * 2048 * 2);
constexpr size_t OFF_WK2 = AL(OFF_WV1 + (size_t)DEPTH * 128 * 2048 * 2);
constexpr size_t OFF_WV2 = AL(OFF_WK2 + (size_t)DEPTH * 64 * 128 * 2);
constexpr size_t OFF_XN = AL(OFF_WV2 + (size_t)DEPTH * 64 * 128 * 2);
constexpr size_t OFF_H = AL(OFF_XN + (size_t)TOK * DM * 2);
constexpr size_t OFF_VT = AL(OFF_H + (size_t)TOK * HS * 2);
constexpr size_t OFF_KCMP = AL(OFF_VT + (size_t)NBATCH * VTC * SEQ * 2);
constexpr size_t OFF_VCMP = AL(OFF_KCMP + (size_t)NBATCH * 2 * 128 * 64 * 2);
constexpr size_t WS_NEED = AL(OFF_VCMP + (size_t)NBATCH * 2 * 64 * 128 * 2);
#define P_CTR ((int*)(p.ws + OFF_CTR))
#define P_LAM ((float*)(p.ws + OFF_LAM))
#define P_WIN_T ((u16*)(p.ws + OFF_WIN))
#define P_WOUT_T ((u16*)(p.ws + OFF_WOUT))
#define P_WK1_T ((u16*)(p.ws + OFF_WK1))
#define P_WV1_T ((u16*)(p.ws + OFF_WV1))
#define P_WK2_T ((u16*)(p.ws + OFF_WK2))
#define P_WV2_T ((u16*)(p.ws + OFF_WV2))
#define P_XN ((u16*)(p.ws + OFF_XN))
#define P_H ((u16*)(p.ws + OFF_H))
#define P_VT ((u16*)(p.ws + OFF_VT))
#define P_KCMP ((u16*)(p.ws + OFF_KCMP))
#define P_VCMP_T ((u16*)(p.ws + OFF_VCMP))

__device__ __forceinline__ int otid() { int t = threadIdx.x; asm volatile("" : "+v"(t)); return t; }
__device__ __forceinline__ float bf2f(u16 b) { return __uint_as_float(((unsigned)b) << 16); }
typedef __attribute__((ext_vector_type(2))) float f32x2;
typedef __attribute__((ext_vector_type(2))) __bf16 bf16x2_t;
__device__ __forceinline__ unsigned pack2(float lo, float hi) {
  f32x2 v = {lo, hi};
  bf16x2_t b = __builtin_convertvector(v, bf16x2_t);
  return __builtin_bit_cast(unsigned, b);
}
__device__ __forceinline__ bf16x8 pack8(float a0, float a1, float a2, float a3, float a4, float a5, float a6, float a7) {
  u32x4 u;
  u[0] = pack2(a0, a1); u[1] = pack2(a2, a3); u[2] = pack2(a4, a5); u[3] = pack2(a6, a7);
  return __builtin_bit_cast(bf16x8, u);
}
__device__ __forceinline__ f32x4 mfma16(bf16x8 a, bf16x8 b, f32x4 c) {
  return __builtin_amdgcn_mfma_f32_16x16x32_bf16(a, b, c, 0, 0, 0);
}
__device__ __forceinline__ float fexp2(float x) { return __builtin_amdgcn_exp2f(x); }
__device__ __forceinline__ float silu_f(float x) { return x * __builtin_amdgcn_rcpf(1.f + __expf(-x)); }
__device__ __forceinline__ float sigmoid_f(float x) { return __builtin_amdgcn_rcpf(1.f + __expf(-x)); }
__device__ __forceinline__ float quad_max(float v) {
  v = fmaxf(v, __shfl_xor(v, 16)); v = fmaxf(v, __shfl_xor(v, 32)); return v;
}
__device__ __forceinline__ float quad_sum(float v) {
  v += __shfl_xor(v, 16); v += __shfl_xor(v, 32); return v;
}

constexpr int SM_MAIN = 73728;
constexpr int SM_IMP = 4 * 32 * 33 * 4;
constexpr int SM_IMP_OFF = 36864;
constexpr int SM_TOTAL = SM_MAIN + 256;

struct TItem { const float* src; u16* dst; int K, N, k0, n0; };
__device__ __forceinline__ TItem setup_item(const Params& p, int it) {
  const int n_win = DEPTH * 16 * 58;
  const int n_wout = DEPTH * 16 * 16;
  const int n_w1 = DEPTH * 32 * 2;
  const int n_w2 = DEPTH * 2 * 1;
  TItem t;
  int i = it;
  if (i < n_win) {
    int l = i / (16 * 58); int r = i % (16 * 58); int nt = r / 16, kt = r % 16;
    t.src = p.w_in + (size_t)l * DM * INC; t.dst = P_WIN_T + (size_t)l * HS * DM; t.K = DM; t.N = INC; t.k0 = kt * 64; t.n0 = nt * 64;
    return t;
  }
  i -= n_win;
  if (i < n_wout) {
    int l = i / 256; int r = i % 256; int nt = r / 16, kt = r % 16;
    t.src = p.w_out + (size_t)l * DM * DM; t.dst = P_WOUT_T + (size_t)l * DM * DM; t.K = DM; t.N = DM; t.k0 = kt * 64; t.n0 = nt * 64;
    return t;
  }
  i -= n_wout;
  if (i < 2 * n_w1) {
    int which = i / n_w1; int r = i % n_w1; int l = r / 64; r %= 64; int nt = r / 32, kt = r % 32;
    t.src = (which ? p.wv1 : p.wk1) + (size_t)l * 2048 * 128; t.dst = (which ? P_WV1_T : P_WK1_T) + (size_t)l * 128 * 2048;
    t.K = 2048; t.N = 128; t.k0 = kt * 64; t.n0 = nt * 64;
    return t;
  }
  i -= 2 * n_w1;
  {
    int which = i / n_w2; int r = i % n_w2; int l = r / 2; int kt = r % 2;
    t.src = (which ? p.wv2 : p.wk2) + (size_t)l * 128 * 64; t.dst = (which ? P_WV2_T : P_WK2_T) + (size_t)l * 64 * 128;
    t.K = 128; t.N = 64; t.k0 = kt * 64; t.n0 = 0;
  }
  return t;
}

__device__ void phase_setup(const Params& p, unsigned char* smem) {
  float* tile = (float*)smem;
  const int total = DEPTH * 16 * 58 + DEPTH * 16 * 16 + 2 * DEPTH * 32 * 2 + 2 * DEPTH * 2;
  const int tid = otid();
  const int tx = tid & 63, ty = tid >> 6;
  const int nl = tid >> 2, kc = (tid & 3) * 16;
  const int G = gridDim.x;
  int it = blockIdx.x;
  TItem cur, nxt, nx2;
  float vals[16], nvals[16], nvals2[16];
  if (it < total) {
    cur = setup_item(p, it);
#pragma unroll
    for (int i = 0; i < 16; ++i) {
      int n = cur.n0 + tx;
      vals[i] = (n < cur.N) ? cur.src[(size_t)(cur.k0 + ty + 4 * i) * cur.N + n] : 0.f;
    }
  }
  if (it + G < total) {
    nxt = setup_item(p, it + G);
#pragma unroll
    for (int i = 0; i < 16; ++i) {
      int n = nxt.n0 + tx;
      nvals[i] = (n < nxt.N) ? nxt.src[(size_t)(nxt.k0 + ty + 4 * i) * nxt.N + n] : 0.f;
    }
  }
  while (it < total) {
    const int nit = it + G;
    const int nit2 = it + 2 * G;
    if (nit2 < total) {
      nx2 = setup_item(p, nit2);
#pragma unroll
      for (int i = 0; i < 16; ++i) {
        int n = nx2.n0 + tx;
        nvals2[i] = (n < nx2.N) ? nx2.src[(size_t)(nx2.k0 + ty + 4 * i) * nx2.N + n] : 0.f;
      }
    }
    __syncthreads();
#pragma unroll
    for (int i = 0; i < 16; ++i) tile[(ty + 4 * i) * 65 + tx] = vals[i];
    __syncthreads();
    u32x4 a, b;
#pragma unroll
    for (int j = 0; j < 4; ++j) {
      a[j] = pack2(tile[(kc + 2 * j) * 65 + nl], tile[(kc + 2 * j + 1) * 65 + nl]);
      b[j] = pack2(tile[(kc + 8 + 2 * j) * 65 + nl], tile[(kc + 8 + 2 * j + 1) * 65 + nl]);
    }
    u16* d = cur.dst + (size_t)(cur.n0 + nl) * cur.K + cur.k0 + kc;
    *(u32x4*)d = a;
    *(u32x4*)(d + 8) = b;
#pragma unroll
    for (int i = 0; i < 16; ++i) { vals[i] = nvals[i]; nvals[i] = nvals2[i]; }
    cur = nxt; nxt = nx2;
    it = nit;
  }
  const int lt_ = otid();
  if (blockIdx.x == 0 && lt_ < DEPTH) {
    int l = lt_;
    float s1 = 0.f, s2 = 0.f;
    for (int i = 0; i < 32; ++i) {
      s1 += p.lq1[l * 32 + i] * p.lk1[l * 32 + i];
      s2 += p.lq2[l * 32 + i] * p.lk2[l * 32 + i];
    }
    float lam_init = 0.8f - 0.6f * expf(-0.3f * (float)l);
    P_LAM[l] = expf(s1) - expf(s2) + lam_init;
  }
}

template <int MODE>
__device__ void phase_rmsnorm(const float* src, const float* __restrict__ w, u16* __restrict__ dstb, float* dstf) {
  const int tid_ = otid();
  const int lane = tid_ & 63;
  const int gw = blockIdx.x * 4 + (tid_ >> 6);
  const int nw = gridDim.x * 4;
  float4 ww[4];
#pragma unroll
  for (int i = 0; i < 4; ++i) ww[i] = *(const float4*)(w + (i * 64 + lane) * 4);
  float4 v[4], nv[4];
  int row = gw;
  if (row < TOK) {
#pragma unroll
    for (int i = 0; i < 4; ++i) v[i] = *(const float4*)(src + (size_t)row * DM + (i * 64 + lane) * 4);
  }
  while (row < TOK) {
    const int nrow = row + nw;
    if (nrow < TOK) {
#pragma unroll
      for (int i = 0; i < 4; ++i) nv[i] = *(const float4*)(src + (size_t)nrow * DM + (i * 64 + lane) * 4);
    }
    float ss = 0.f;
#pragma unroll
    for (int i = 0; i < 4; ++i) ss += v[i].x * v[i].x + v[i].y * v[i].y + v[i].z * v[i].z + v[i].w * v[i].w;
#pragma unroll
    for (int o = 1; o < 64; o <<= 1) ss += __shfl_xor(ss, o);
    float rstd = rsqrtf(ss * (1.f / DM) + 1e-6f);
#pragma unroll
    for (int i = 0; i < 4; ++i) {
      int c = (i * 64 + lane) * 4;
      float a0 = v[i].x * rstd * ww[i].x, a1 = v[i].y * rstd * ww[i].y, a2 = v[i].z * rstd * ww[i].z, a3 = v[i].w * rstd * ww[i].w;
      if (MODE == 0) {
        uint2 o2; o2.x = pack2(a0, a1); o2.y = pack2(a2, a3);
        *(uint2*)(dstb + (size_t)row * DM + c) = o2;
      } else {
        float4 o4; o4.x = a0; o4.y = a1; o4.z = a2; o4.w = a3;
        *(float4*)(dstf + (size_t)row * DM + c) = o4;
      }
    }
#pragma unroll
    for (int i = 0; i < 4; ++i) v[i] = nv[i];
    row = nrow;
  }
}

constexpr int G2S = 32;
constexpr int G2STAGE = (256 + 128) * G2S;
template <int MODE>
__device__ void gemm_tile2(const u16* __restrict__ X, int lda, const u16* __restrict__ W, int ldb, int K,
                           int m0, int n0, u16* __restrict__ outb, int vbase,
                           const float* resid, float* outf, unsigned char* smem) {
  u16* sbase = (u16*)smem;
  const int tid = otid(), lane = tid & 63, l15 = lane & 15, quad = lane >> 4;
  const int wave = tid >> 6;
  const int wx = wave >> 1, ww = wave & 1;
  f32x4 acc[8][4];
#pragma unroll
  for (int i = 0; i < 8; ++i)
#pragma unroll
    for (int j = 0; j < 4; ++j) acc[i][j] = f32x4{0.f, 0.f, 0.f, 0.f};
  u32x4 rx[2][4], rw[2][2];
  const int lrow = tid >> 2, lkc = (tid & 3) * 8;
  const int lsw = ((tid & 3) ^ ((0 - (lrow >> 2)) & 3)) * 8;
  const int fsw = (quad ^ ((0 - (l15 >> 2)) & 3)) * 8;
  const auto rsX = __builtin_amdgcn_make_buffer_rsrc((void*)(X + (size_t)m0 * lda), (short)0, 0x7fffffff, 0x00020000);
  const auto rsW = __builtin_amdgcn_make_buffer_rsrc((void*)(W + (size_t)n0 * ldb), (short)0, 0x7fffffff, 0x00020000);
  const int vox = (lrow * lda + lkc) * 2, vow = (lrow * ldb + lkc) * 2;
  const int nk = K / 32;
#define G2_GLOAD(S_, KT_)                                                                                      \
  {                                                                                                            \
    _Pragma("unroll") for (int i = 0; i < 4; ++i)                                                              \
      rx[S_][i] = __builtin_amdgcn_raw_buffer_load_b128(rsX, vox, i * 64 * lda * 2 + (KT_) * 64, 0);           \
    _Pragma("unroll") for (int i = 0; i < 2; ++i)                                                              \
      rw[S_][i] = __builtin_amdgcn_raw_buffer_load_b128(rsW, vow, i * 64 * ldb * 2 + (KT_) * 64, 0);           \
  }
#define G2_LSTORE(S_, ST_)                                                                                     \
  {                                                                                                            \
    u16* s_ = sbase + (ST_) * G2STAGE;                                                                         \
    _Pragma("unroll") for (int i = 0; i < 4; ++i) *(u32x4*)(s_ + (lrow + i * 64) * G2S + lsw) = rx[S_][i];     \
    _Pragma("unroll") for (int i = 0; i < 2; ++i) *(u32x4*)(s_ + 256 * G2S + (lrow + i * 64) * G2S + lsw) = rw[S_][i]; \
  }
  G2_GLOAD(0, 0);
  G2_GLOAD(1, 1);
  __syncthreads();
  G2_LSTORE(0, 0);
  G2_GLOAD(0, 2);
  __syncthreads();
  for (int kt2 = 0; kt2 < nk; kt2 += 2) {
#pragma unroll
    for (int h = 0; h < 2; ++h) {
      const int kt = kt2 + h;
      const u16* st = sbase + h * G2STAGE;
      bf16x8 fw[4], fx[4];
#pragma unroll
      for (int j = 0; j < 4; ++j) fw[j] = *(const bf16x8*)(st + 256 * G2S + (ww * 64 + j * 16 + l15) * G2S + fsw);
#pragma unroll
      for (int i = 0; i < 4; ++i) fx[i] = *(const bf16x8*)(st + (wx * 128 + i * 16 + l15) * G2S + fsw);
      __builtin_amdgcn_sched_barrier(0);
      __builtin_amdgcn_s_setprio(1);
#pragma unroll
      for (int i = 0; i < 4; ++i) {
#pragma unroll
        for (int j = 0; j < 4; ++j) {
          if (MODE == 1) acc[i][j] = mfma16(fx[i], fw[j], acc[i][j]);
          else acc[i][j] = mfma16(fw[j], fx[i], acc[i][j]);
        }
      }
      __builtin_amdgcn_s_setprio(0);
      __builtin_amdgcn_sched_barrier(0);
#pragma unroll
      for (int i = 0; i < 4; ++i) fx[i] = *(const bf16x8*)(st + (wx * 128 + (i + 4) * 16 + l15) * G2S + fsw);
      __builtin_amdgcn_sched_barrier(0);
      if (kt + 1 < nk) G2_LSTORE(1 - h, 1 - h);
      if (kt + 3 < nk) G2_GLOAD(1 - h, kt + 3);
      __builtin_amdgcn_sched_barrier(0);
      __builtin_amdgcn_s_setprio(1);
#pragma unroll
      for (int i = 0; i < 4; ++i) {
#pragma unroll
        for (int j = 0; j < 4; ++j) {
          if (MODE == 1) acc[i + 4][j] = mfma16(fx[i], fw[j], acc[i + 4][j]);
          else acc[i + 4][j] = mfma16(fw[j], fx[i], acc[i + 4][j]);
        }
      }
      __builtin_amdgcn_s_setprio(0);
      __syncthreads();
    }
  }
#undef G2_GLOAD
#undef G2_LSTORE
  if (MODE == 0) {
    u16* sT = (u16*)smem;
#pragma unroll
    for (int i = 0; i < 8; ++i)
#pragma unroll
      for (int j = 0; j < 4; ++j) {
        f32x4 a = acc[i][j];
        uint2 o; o.x = pack2(a[0], a[1]); o.y = pack2(a[2], a[3]);
        *(uint2*)(sT + (wx * 128 + i * 16 + l15) * 136 + ww * 64 + j * 16 + quad * 4) = o;
      }
    __syncthreads();
    const int ch = tid & 15, r0 = tid >> 4;
#pragma unroll
    for (int ps = 0; ps < 16; ++ps) {
      int row = ps * 16 + r0;
      u32x4 v = *(const u32x4*)(sT + row * 136 + ch * 8);
      *(u32x4*)(outb + (size_t)(m0 + row) * HS + n0 + ch * 8) = v;
    }
  } else if (MODE == 1) {
    u16* sT = (u16*)smem;
#pragma unroll
    for (int i = 0; i < 8; ++i)
#pragma unroll
      for (int j = 0; j < 4; ++j) {
        f32x4 a = acc[i][j];
        uint2 o; o.x = pack2(a[0], a[1]); o.y = pack2(a[2], a[3]);
        *(uint2*)(sT + (ww * 64 + j * 16 + l15) * 264 + wx * 128 + i * 16 + quad * 4) = o;
      }
    __syncthreads();
    const int ch = tid & 31, r0 = tid >> 5;
    const int b = m0 >> 11, s0 = m0 & 2047;
#pragma unroll
    for (int ps = 0; ps < 16; ++ps) {
      int row = ps * 8 + r0;
      u32x4 v = *(const u32x4*)(sT + row * 264 + ch * 8);
      *(u32x4*)(outb + ((size_t)(b * VTC + vbase + row)) * SEQ + s0 + ch * 8) = v;
    }
  } else {
    float* sT = (float*)smem;
    const int ch = tid & 31, r0 = tid >> 5;
#pragma unroll
    for (int half = 0; half < 2; ++half) {
      if (half) __syncthreads();
      if (wx == half) {
#pragma unroll
        for (int i = 0; i < 8; ++i)
#pragma unroll
          for (int j = 0; j < 4; ++j)
            *(f32x4*)(sT + (i * 16 + l15) * 132 + ww * 64 + j * 16 + quad * 4) = acc[i][j];
      }
      __syncthreads();
#pragma unroll
      for (int ps = 0; ps < 16; ++ps) {
        int row = ps * 8 + r0;
        f32x4 v = *(const f32x4*)(sT + row * 132 + ch * 4);
        size_t off = (size_t)(m0 + half * 128 + row) * DM + n0 + ch * 4;
        f32x4 r4 = *(const f32x4*)(resid + off);
        *(f32x4*)(outf + off) = r4 + v;
      }
    }
  }
}

__device__ void phase_inproj(const Params& p, int layer, unsigned char* smem) {
  const u16* W = P_WIN_T + (size_t)layer * HS * DM;
  const int xcd = blockIdx.x & 7, loc = blockIdx.x >> 3, nloc = gridDim.x >> 3;
  for (int idx = loc; idx < 8 * NT_IN; idx += nloc) {
    int grp = idx / (4 * NT_IN), within = idx % (4 * NT_IN);
    int nt = within >> 2, mt = xcd * 8 + grp * 4 + (within & 3);
    int vbase = -1;
    if (nt == 4) vbase = 0; else if (nt == 5) vbase = 128; else if (nt == 11) vbase = 256;
    else if (nt == 21) vbase = 384; else if (nt == 23) vbase = 512;
    if (vbase >= 0) gemm_tile2<1>(P_XN, DM, W, DM, DM, mt * 256, nt * 128, P_VT, vbase, nullptr, nullptr, smem);
    else gemm_tile2<0>(P_XN, DM, W, DM, DM, mt * 256, nt * 128, P_H, 0, nullptr, nullptr, smem);
  }
}

__device__ void phase_outproj(const Params& p, int layer, unsigned char* smem) {
  const u16* W = P_WOUT_T + (size_t)layer * DM * DM;
  const float* resid = (layer == 0) ? p.x : p.out;
  const int xcd = blockIdx.x & 7, loc = blockIdx.x >> 3, nloc = gridDim.x >> 3;
  for (int idx = loc; idx < 8 * 8; idx += nloc) {
    int nt = idx >> 3, mt = xcd * 8 + (idx & 7);
    gemm_tile2<2>(P_XN, DM, W, DM, DM, mt * 256, nt * 128, nullptr, 0, resid, p.out, smem);
  }
}

template <bool MASKED>
__device__ __forceinline__ void sm_step(f32x4 (&S)[4], float c1, float slope2, float tb, int kbase, int tqn,
                                        int window, bool selok, bf16x8 (&pb)[2]) {
#pragma unroll
  for (int mt = 0; mt < 4; ++mt)
#pragma unroll
    for (int r = 0; r < 4; ++r) {
      float u = fmaf(slope2, (float)(mt * 16 + r), fmaf(S[mt][r], c1, tb));
      if (MASKED) {
        int dist = tqn - (kbase + mt * 16 + r);
        bool valid = (dist >= 0) && (dist < window) && selok;
        u = valid ? u : -1e30f;
      }
      S[mt][r] = fexp2(u);
    }
#pragma unroll
  for (int k2 = 0; k2 < 2; ++k2)
    pb[k2] = pack8(S[2 * k2][0], S[2 * k2][1], S[2 * k2][2], S[2 * k2][3],
                   S[2 * k2 + 1][0], S[2 * k2 + 1][1], S[2 * k2 + 1][2], S[2 * k2 + 1][3]);
}

__device__ __forceinline__ bf16x8 vt_frag(const u16* sVt, int dt, int k2, int l15, int quad) {
  const u16* vp = sVt + (dt * 16 + l15) * 72 + k2 * 32 + quad * 4;
  uint2 lo = *(const uint2*)vp;
  uint2 hi = *(const uint2*)(vp + 16);
  u32x4 u; u[0] = lo.x; u[1] = lo.y; u[2] = hi.x; u[3] = hi.y;
  return __builtin_bit_cast(bf16x8, u);
}

struct NoHook { __device__ __forceinline__ void operator()() const {} };
template <bool SEL, int NMAP, int NQ, int TK = 1, class HOOK = NoHook>
__device__ __forceinline__ void flash_pass(const u16* __restrict__ Kg, int kstride, const u16* __restrict__ Vtg, int vtstride,
                                           int kt_begin, int kt_end, unsigned tilemask,
                                           const bf16x8 (&qf)[NQ][2], const int (&tq)[NQ], int qlo, int qhi,
                                           float slope2, int window, const unsigned (&selq)[NQ], float c1,
                                           f32x4 (&O)[NQ * NMAP][4], float (&l)[NQ * NMAP], u16* sK, u16* sVt,
                                           HOOK hook = HOOK()) {
  const int tid = otid(), lane = tid & 63, l15 = lane & 15, quad = lane >> 4;
  const int lrow = tid >> 3, lkc = (tid & 7) * 8;
  const u16* gk = Kg + (size_t)lrow * kstride + lkc;
  const u16* gv = Vtg + (size_t)lrow * vtstride + lkc;
  constexpr int TSZ = 2 * 64 * 72;
  constexpr int FST = TK * TSZ;
  u16* wk = sK + lrow * 64 + ((tid & 7) ^ ((lrow >> 1) & 7)) * 8;
  u16* wv = sK + 64 * 72 + lrow * 72 + lkc;
  int kt = kt_begin;
  if (SEL) {
    unsigned rem = tilemask >> kt;
    kt = rem ? kt + __ffs(rem) - 1 : kt_end;
  }
  auto next_tile = [&](int k) -> int {
    if (!SEL) return k + TK;
    unsigned rem = (k + 1 < 32) ? (tilemask >> (k + 1)) : 0u;
    return rem ? k + 1 + __ffs(rem) - 1 : kt_end;
  };
  u32x4 rk[TK][2], rv[TK][2];
  auto gload = [&](int k) {
#pragma unroll
    for (int t = 0; t < TK; ++t)
#pragma unroll
      for (int i = 0; i < 2; ++i) {
        rk[t][i] = *(const u32x4*)(gk + (size_t)((k + t) * 64 + i * 32) * kstride);
        rv[t][i] = *(const u32x4*)(gv + (size_t)(i * 32) * vtstride + (k + t) * 64);
      }
  };
  auto lstore = [&](int st) {
#pragma unroll
    for (int t = 0; t < TK; ++t)
#pragma unroll
      for (int i = 0; i < 2; ++i) {
        *(u32x4*)(wk + st * FST + t * TSZ + i * 32 * 64) = rk[t][i];
        *(u32x4*)(wv + st * FST + t * TSZ + i * 32 * 72) = rv[t][i];
      }
  };
  if (kt >= kt_end) { hook(); return; }
  const bf16x8 ones = bf16x8{0x3F80, 0x3F80, 0x3F80, 0x3F80, 0x3F80, 0x3F80, 0x3F80, 0x3F80};
  f32x4 L[NQ * NMAP];
#pragma unroll
  for (int i = 0; i < NQ * NMAP; ++i) L[i] = f32x4{0.f, 0.f, 0.f, 0.f};
  int nxt = next_tile(kt);
  {
    u32x4 fk[TK][2], fv[TK][2];
#pragma unroll
    for (int t = 0; t < TK; ++t)
#pragma unroll
      for (int i = 0; i < 2; ++i) {
        fk[t][i] = *(const u32x4*)(gk + (size_t)((kt + t) * 64 + i * 32) * kstride);
        fv[t][i] = *(const u32x4*)(gv + (size_t)(i * 32) * vtstride + (kt + t) * 64);
      }
    if (nxt < kt_end) gload(nxt);
    hook();
    __syncthreads();
#pragma unroll
    for (int t = 0; t < TK; ++t)
#pragma unroll
      for (int i = 0; i < 2; ++i) {
        *(u32x4*)(wk + t * TSZ + i * 32 * 64) = fk[t][i];
        *(u32x4*)(wv + t * TSZ + i * 32 * 72) = fv[t][i];
      }
  }
  __syncthreads();
  int stg = 0;
  while (kt < kt_end) {
    const int nxt2 = (nxt < kt_end) ? next_tile(nxt) : kt_end;
    if (nxt < kt_end) lstore(stg ^ 1);
    if (nxt2 < kt_end) gload(nxt2);
#pragma unroll
    for (int hk = 0; hk < TK; ++hk) {
    const u16* cK = sK + stg * FST + hk * TSZ;
    const u16* cV = cK + 64 * 72;
    const int k0 = (kt + hk) * 64;
    if (k0 <= qhi && (qlo - (k0 + 63)) < window) {
      bool full = (k0 + 63 <= qlo) && (qhi - k0 < window);
      const bool rowfull = SEL && full;
      bool selok[NQ];
#pragma unroll
      for (int n = 0; n < NQ; ++n) selok[n] = true;
      if (SEL) {
        bool all = true;
#pragma unroll
        for (int n = 0; n < NQ; ++n) { selok[n] = ((selq[n] >> kt) & 1u) != 0; all = all && selok[n]; }
        full = full && __all(all);
      }
      const int kbase = k0 + quad * 4;
#pragma unroll
      for (int mp = 0; mp < NMAP; ++mp) {
#pragma unroll
        for (int n = 0; n < NQ; ++n) {
          f32x4 S[4];
#pragma unroll
          for (int mt = 0; mt < 4; ++mt) S[mt] = f32x4{0.f, 0.f, 0.f, 0.f};
#pragma unroll
          for (int ks = 0; ks < 2; ++ks) {
            if (NMAP == 2 && ks != mp) continue;
#pragma unroll
            for (int mt = 0; mt < 4; ++mt) {
              bf16x8 a = *(const bf16x8*)(cK + (mt * 16 + l15) * 64 + (((ks * 4 + quad) ^ ((l15 >> 1) & 7)) * 8));
              S[mt] = mfma16(a, qf[n][ks], S[mt]);
            }
          }
          bf16x8 pb[2];
          const float tb = slope2 * (float)(kbase - tq[n]);
          if (full || rowfull) {
            sm_step<false>(S, c1, slope2, tb, kbase, tq[n], window, true, pb);
            if (SEL && !full && !selok[n]) {
              pb[0] = bf16x8{0, 0, 0, 0, 0, 0, 0, 0}; pb[1] = bf16x8{0, 0, 0, 0, 0, 0, 0, 0};
            }
          } else sm_step<true>(S, c1, slope2, tb, kbase, tq[n], window, selok[n], pb);
#pragma unroll
          for (int k2 = 0; k2 < 2; ++k2) {
#pragma unroll
            for (int dt = 0; dt < 4; ++dt) {
              bf16x8 a = vt_frag(cV, dt, k2, l15, quad);
              O[mp * NQ + n][dt] = mfma16(a, pb[k2], O[mp * NQ + n][dt]);
            }
            L[mp * NQ + n] = mfma16(ones, pb[k2], L[mp * NQ + n]);
          }
        }
      }
    }
    }
    __syncthreads();
    kt = nxt; nxt = nxt2; stg ^= 1;
  }
#pragma unroll
  for (int i = 0; i < NQ * NMAP; ++i) l[i] = L[i][0];
}

__device__ void item_diff(const Params& p, int layer, int b, int hd, int qt, unsigned char* smem) {
  u16* sK = (u16*)smem;
  u16* sVt = sK + 64 * 72;
  const int tid = otid(), lane = tid & 63, l15 = lane & 15, quad = lane >> 4;
  const int wave = __builtin_amdgcn_readfirstlane(tid >> 6);
  const int q0 = qt * 64;
  const int qlo = q0 + wave * 16;
  int tq[1];
  tq[0] = qlo + l15;
  const float slope2 = exp2f(-2.f * (float)(hd + 1)) * LOG2E;
  const unsigned selq[1] = {0xffffffffu};
  const float c1 = 0.17677669529663687f * LOG2E;
  const float lam = P_LAM[layer];
  const float lam_init = 0.8f - 0.6f * expf(-0.3f * (float)layer);
  const u16* hb = P_H + (size_t)b * SEQ * HS;
  const u16* vt = P_VT + ((size_t)b * VTC + hd * 64) * SEQ;
  bf16x8 qf[1][2];
#pragma unroll
  for (int ks = 0; ks < 2; ++ks)
    qf[0][ks] = *(const bf16x8*)(hb + (size_t)tq[0] * HS + C_QA + hd * 64 + ks * 32 + quad * 8);
  uint2 gpre[4];
#pragma unroll
  for (int dt = 0; dt < 4; ++dt)
    gpre[dt] = *(const uint2*)(hb + (size_t)tq[0] * HS + C_GA + hd * 64 + dt * 16 + quad * 4);
  f32x4 O[2][4];
  float l[2] = {0.f, 0.f};
#pragma unroll
  for (int i = 0; i < 2; ++i)
#pragma unroll
    for (int dt = 0; dt < 4; ++dt) O[i][dt] = f32x4{0.f, 0.f, 0.f, 0.f};
  flash_pass<false, 2, 1, 2>(hb + C_KA + hd * 64, HS, vt, SEQ, 0, (qt + 2) & ~1, 0u, qf, tq, qlo, qlo + 15, slope2,
                          0x7fffffff, selq, c1, O, l, sK, sVt);
  {
    const float inv1 = 1.f / l[0];
    const float inv2 = lam / l[1];
    f32x4 Of[4];
    float ss = 0.f;
#pragma unroll
    for (int dt = 0; dt < 4; ++dt) {
      Of[dt] = O[0][dt] * inv1 - O[1][dt] * inv2;
#pragma unroll
      for (int r = 0; r < 4; ++r) ss += Of[dt][r] * Of[dt][r];
    }
    ss = quad_sum(ss);
    float rstd = rsqrtf(ss * (1.f / 64.f) + 1e-6f) * (1.f - lam_init);
    const size_t tok = (size_t)b * SEQ + tq[0];
#pragma unroll
    for (int dt = 0; dt < 4; ++dt) {
      int d = dt * 16 + quad * 4;
      float4 sw = *(const float4*)(p.subln + layer * 64 + d);
      uint2 g2 = gpre[dt];
      float g0 = bf2f((u16)(g2.x & 0xffff)), g1 = bf2f((u16)(g2.x >> 16)), g2f = bf2f((u16)(g2.y & 0xffff)), g3 = bf2f((u16)(g2.y >> 16));
      float o0 = Of[dt][0] * rstd * sw.x * silu_f(g0);
      float o1 = Of[dt][1] * rstd * sw.y * silu_f(g1);
      float o2 = Of[dt][2] * rstd * sw.z * silu_f(g2f);
      float o3 = Of[dt][3] * rstd * sw.w * silu_f(g3);
      uint2 o; o.x = pack2(o0, o1); o.y = pack2(o2, o3);
      *(uint2*)(P_XN + tok * DM + hd * 64 + d) = o;
    }
  }
}

__device__ void item_swa(const Params& p, int layer, int b, int g, int qt, unsigned char* smem) {
  u16* sK = (u16*)smem;
  u16* sVt = sK + 64 * 72;
  const int tid = otid(), lane = tid & 63, l15 = lane & 15, quad = lane >> 4;
  const int wave = __builtin_amdgcn_readfirstlane(tid >> 6);
  const int q0 = qt * 64;
  const int hh = g * 2 + (wave >> 1);
  const int qlo = q0 + (wave & 1) * 32;
  int tq[2];
  tq[0] = qlo + l15; tq[1] = tq[0] + 16;
  const float slope2 = exp2f(-2.f * (float)(hh + 1)) * LOG2E;
  const unsigned selq[2] = {0xffffffffu, 0xffffffffu};
  const float c1 = 0.125f * LOG2E;
  const u16* hb = P_H + (size_t)b * SEQ * HS;
  const u16* vt = P_VT + ((size_t)b * VTC + 256 + g * 64) * SEQ;
  bf16x8 qf[2][2];
#pragma unroll
  for (int n = 0; n < 2; ++n)
#pragma unroll
    for (int ks = 0; ks < 2; ++ks)
      qf[n][ks] = *(const bf16x8*)(hb + (size_t)tq[n] * HS + C_QB + hh * 64 + ks * 32 + quad * 8);
  uint2 gpre[2][4];
#pragma unroll
  for (int n = 0; n < 2; ++n)
#pragma unroll
    for (int dt = 0; dt < 4; ++dt)
      gpre[n][dt] = *(const uint2*)(hb + (size_t)tq[n] * HS + C_GB + hh * 64 + dt * 16 + quad * 4);
  f32x4 O[2][4];
  float l[2] = {0.f, 0.f};
#pragma unroll
  for (int n = 0; n < 2; ++n)
#pragma unroll
    for (int dt = 0; dt < 4; ++dt) O[n][dt] = f32x4{0.f, 0.f, 0.f, 0.f};
  int ktb = qt - 2; if (ktb < 0) ktb = 0;
  int kte = qt + 1;
  if ((kte - ktb) & 1) { if (ktb > 0) --ktb; else ++kte; }
  flash_pass<false, 1, 2, 2>(hb + C_KB + g * 64, HS, vt, SEQ, ktb, kte, 0u, qf, tq, qlo, qlo + 31, slope2, 128, selq, c1,
                             O, l, sK, sVt);
  const float sink2 = p.sinks[layer * 4 + hh] * LOG2E;
#pragma unroll
  for (int n = 0; n < 2; ++n) {
    float lt = l[n] + fexp2(sink2);
    float inv = 1.f / lt;
    const size_t tok = (size_t)b * SEQ + tq[n];
#pragma unroll
    for (int dt = 0; dt < 4; ++dt) {
      int d = dt * 16 + quad * 4;
      uint2 g2 = gpre[n][dt];
      float g0 = bf2f((u16)(g2.x & 0xffff)), g1 = bf2f((u16)(g2.x >> 16)), g2f = bf2f((u16)(g2.y & 0xffff)), g3 = bf2f((u16)(g2.y >> 16));
      float o0 = O[n][dt][0] * inv * silu_f(g0);
      float o1 = O[n][dt][1] * inv * silu_f(g1);
      float o2 = O[n][dt][2] * inv * silu_f(g2f);
      float o3 = O[n][dt][3] * inv * silu_f(g3);
      uint2 o; o.x = pack2(o0, o1); o.y = pack2(o2, o3);
      *(uint2*)(P_XN + tok * DM + 256 + hh * 64 + d) = o;
    }
  }
}

__device__ void item_compress(const Params& p, int layer, int kv, int b, int g, int ct, unsigned char* smem) {
  float* sP = (float*)smem;
  u16* sH = (u16*)(smem + 4 * 16 * 132 * 4);
  const int tid = otid(), wave = tid >> 6, lane = tid & 63, l15 = lane & 15, quad = lane >> 4;
  const int c0 = ct * 16;
  const int c = c0 + l15;
  const bool cvalid = c < 127;
  const int col = (kv ? C_VC : C_KC) + g * 64;
  const float* pe = (kv ? p.pe_v : p.pe_k) + (size_t)layer * 32 * 64;
  const u16* w1t = (kv ? P_WV1_T : P_WK1_T) + (size_t)layer * 128 * 2048;
  const u16* w2t = (kv ? P_WV2_T : P_WK2_T) + (size_t)layer * 64 * 128;
  const u16* src = P_H + ((size_t)b * SEQ + (size_t)(cvalid ? 16 * c : 0)) * HS + col + quad * 8;
  const u16* wb = w1t + (size_t)l15 * 2048 + quad * 8;
  f32x4 acc[8];
#pragma unroll
  for (int j = 0; j < 8; ++j) acc[j] = f32x4{0.f, 0.f, 0.f, 0.f};
#pragma unroll 2
  for (int ii = 0; ii < 8; ++ii) {
    const int i = wave * 8 + ii;
#pragma unroll
    for (int ks = 0; ks < 2; ++ks) {
      uint4 raw = *(const uint4*)(src + (size_t)i * HS + ks * 32);
      const float* pp = pe + i * 64 + ks * 32 + quad * 8;
      float4 p0 = *(const float4*)pp, p1 = *(const float4*)(pp + 4);
      bf16x8 a = pack8(bf2f((u16)(raw.x & 0xffff)) + p0.x, bf2f((u16)(raw.x >> 16)) + p0.y,
                       bf2f((u16)(raw.y & 0xffff)) + p0.z, bf2f((u16)(raw.y >> 16)) + p0.w,
                       bf2f((u16)(raw.z & 0xffff)) + p1.x, bf2f((u16)(raw.z >> 16)) + p1.y,
                       bf2f((u16)(raw.w & 0xffff)) + p1.z, bf2f((u16)(raw.w >> 16)) + p1.w);
#pragma unroll
      for (int j = 0; j < 8; ++j) {
        bf16x8 bfr = *(const bf16x8*)(wb + (size_t)(j * 16) * 2048 + i * 64 + ks * 32);
        acc[j] = mfma16(a, bfr, acc[j]);
      }
    }
  }
  __syncthreads();
#pragma unroll
  for (int j = 0; j < 8; ++j)
#pragma unroll
    for (int r = 0; r < 4; ++r) sP[(wave * 16 + quad * 4 + r) * 132 + j * 16 + l15] = acc[j][r];
  __syncthreads();
#pragma unroll
  for (int e = 0; e < 8; ++e) {
    int idx = e * 256 + tid;
    int row = idx >> 7, cc = idx & 127;
    float v = ((sP[row * 132 + cc] + sP[(16 + row) * 132 + cc]) + sP[(32 + row) * 132 + cc]) + sP[(48 + row) * 132 + cc];
    v = silu_f(v);
    sH[row * 136 + cc] = (u16)(pack2(v, 0.f) & 0xffff);
  }
  __syncthreads();
  f32x4 a2 = f32x4{0.f, 0.f, 0.f, 0.f};
#pragma unroll
  for (int ks = 0; ks < 4; ++ks) {
    bf16x8 a = *(const bf16x8*)(sH + l15 * 136 + ks * 32 + quad * 8);
    bf16x8 bb = *(const bf16x8*)(w2t + (size_t)(wave * 16 + l15) * 128 + ks * 32 + quad * 8);
    a2 = mfma16(a, bb, a2);
  }
  const int d = wave * 16 + l15;
  const int cc = c0 + quad * 4;
  float v0 = a2[0], v1 = a2[1], v2 = a2[2], v3 = (cc + 3 < 127) ? a2[3] : 0.f;
  if (kv == 0) {
    u16* dst = P_KCMP + ((size_t)(b * 2 + g) * 128 + cc) * 64 + d;
    dst[0] = (u16)(pack2(v0, 0.f) & 0xffff);
    dst[64] = (u16)(pack2(v1, 0.f) & 0xffff);
    dst[128] = (u16)(pack2(v2, 0.f) & 0xffff);
    dst[192] = (u16)(pack2(v3, 0.f) & 0xffff);
  } else {
    uint2 o; o.x = pack2(v0, v1); o.y = pack2(v2, v3);
    *(uint2*)(P_VCMP_T + ((size_t)(b * 2 + g) * 64 + d) * 128 + cc) = o;
  }
}

__device__ void item_nsa(const Params& p, int layer, int b, int g, int qt, unsigned char* smem) {
  u16* sK = (u16*)smem;
  u16* sVt = sK + 64 * 72;
  u16* sK2 = (u16*)smem;
  u16* sV2 = sK2 + 128 * 72;
  float* sImp = (float*)(smem + SM_IMP_OFF);
  unsigned* sSel = (unsigned*)(smem + SM_MAIN);
  const int tid = otid(), lane = tid & 63, l15 = lane & 15, quad = lane >> 4;
  const int wave = __builtin_amdgcn_readfirstlane(tid >> 6);
  const int q0 = qt * 32;
  const int hh = g * 4 + wave;
  int tq[2];
  tq[0] = q0 + l15; tq[1] = tq[0] + 16;
  const float slope = exp2f(-(float)(hh + 1));
  float slope2[2] = {slope * LOG2E, slope * LOG2E};
  const float c1 = 0.125f * LOG2E;
  const u16* hb = P_H + (size_t)b * SEQ * HS;
  bf16x8 qf[2][2];
  float gate[2][3];
#pragma unroll
  for (int n = 0; n < 2; ++n) {
#pragma unroll
    for (int ks = 0; ks < 2; ++ks)
      qf[n][ks] = *(const bf16x8*)(hb + (size_t)tq[n] * HS + C_QC + hh * 64 + ks * 32 + quad * 8);
#pragma unroll
    for (int i = 0; i < 3; ++i) gate[n][i] = sigmoid_f(bf2f(hb[(size_t)tq[n] * HS + C_GL + hh * 3 + i]));
  }
  f32x4 Of[2][4];
  {
    const u16* kc = P_KCMP + (size_t)(b * 2 + g) * 128 * 64;
    const u16* vc = P_VCMP_T + (size_t)(b * 2 + g) * 64 * 128;
    __syncthreads();
#pragma unroll
    for (int c = tid; c < 1024; c += 256) {
      int key = c >> 3, kc8 = (c & 7) * 8;
      *(uint4*)(sK2 + key * 64 + (((c & 7) ^ ((key >> 1) & 7)) * 8)) = *(const uint4*)(kc + key * 64 + kc8);
    }
#pragma unroll
    for (int c = tid; c < 1024; c += 256) {
      int d = c >> 4, kc8 = (c & 15) * 8;
      *(uint4*)(sV2 + d * 136 + kc8) = *(const uint4*)(vc + d * 128 + kc8);
    }
    if (tid < 33) sSel[tid] = 0u;
    __syncthreads();
#pragma unroll
    for (int n = 0; n < 2; ++n) {
      f32x4 S[8];
#pragma unroll
      for (int mt = 0; mt < 8; ++mt) S[mt] = f32x4{0.f, 0.f, 0.f, 0.f};
#pragma unroll
      for (int ks = 0; ks < 2; ++ks)
#pragma unroll
        for (int mt = 0; mt < 8; ++mt) {
          bf16x8 a = *(const bf16x8*)(sK2 + (mt * 16 + l15) * 64 + (((ks * 4 + quad) ^ ((l15 >> 1) & 7)) * 8));
          S[mt] = mfma16(a, qf[n][ks], S[mt]);
        }
      float mx = -1e30f;
#pragma unroll
      for (int mt = 0; mt < 8; ++mt)
#pragma unroll
        for (int r = 0; r < 4; ++r) {
          int c = mt * 16 + quad * 4 + r;
          int dist = tq[n] - (16 * c + 31);
          bool valid = (dist >= 0) && (c < 127);
          float s = S[mt][r] * c1 - slope2[n] * (float)dist;
          s = valid ? s : -1e30f;
          S[mt][r] = s;
          mx = fmaxf(mx, s);
        }
      mx = quad_max(mx);
      float rs = 0.f;
#pragma unroll
      for (int mt = 0; mt < 8; ++mt)
#pragma unroll
        for (int r = 0; r < 4; ++r) {
          float s = S[mt][r];
          float pv = (s > -5e29f) ? fexp2(s - mx) : 0.f;
          S[mt][r] = pv;
          rs += pv;
        }
      rs = quad_sum(rs);
      float inv = (rs > 0.f) ? 1.f / rs : 0.f;
      float bprev = 0.f;
#pragma unroll
      for (int mt = 0; mt < 8; ++mt) {
        f32x4 pn = S[mt] * inv;
        S[mt] = pn;
        float av = pn[0] + pn[1] + pn[2] + 0.5f * pn[3];
        float bc = 0.5f * pn[3];
        float send = (quad == 3) ? bprev : bc;
        float recv = __shfl(send, (lane + 48) & 63);
        bprev = bc;
        sImp[(wave * 32 + n * 16 + l15) * 33 + mt * 4 + quad] = av + recv;
      }
      bf16x8 pb[4];
#pragma unroll
      for (int k2 = 0; k2 < 4; ++k2)
        pb[k2] = pack8(S[2 * k2][0], S[2 * k2][1], S[2 * k2][2], S[2 * k2][3],
                       S[2 * k2 + 1][0], S[2 * k2 + 1][1], S[2 * k2 + 1][2], S[2 * k2 + 1][3]);
      f32x4 Oc[4];
#pragma unroll
      for (int dt = 0; dt < 4; ++dt) Oc[dt] = f32x4{0.f, 0.f, 0.f, 0.f};
#pragma unroll
      for (int k2 = 0; k2 < 4; ++k2)
#pragma unroll
        for (int dt = 0; dt < 4; ++dt) {
          const u16* vp = sV2 + (dt * 16 + l15) * 136 + k2 * 32 + quad * 4;
          uint2 lo = *(const uint2*)vp;
          uint2 hi = *(const uint2*)(vp + 16);
          u32x4 u; u[0] = lo.x; u[1] = lo.y; u[2] = hi.x; u[3] = hi.y;
          bf16x8 a = __builtin_bit_cast(bf16x8, u);
          Oc[dt] = mfma16(a, pb[k2], Oc[dt]);
        }
#pragma unroll
      for (int dt = 0; dt < 4; ++dt) Of[n][dt] = Oc[dt] * gate[n][0];
    }
  }
  unsigned selq[2] = {0u, 0u};
  unsigned tilemask = 0u;
  const int kt_end = ((q0 + 31) >> 6) + 1;
  u16* sOf = (u16*)sImp + (wave * 32 + l15) * 72 + quad * 4;
  auto sel_hook = [&]() {
    __syncthreads();
  #pragma unroll 1
    for (int e = tid; e < 32 * 33; e += 256) {
      float v = ((sImp[e] + sImp[32 * 33 + e]) + sImp[2 * 32 * 33 + e]) + sImp[3 * 32 * 33 + e];
      sImp[e] = v;
    }
    __syncthreads();
    {
      const int q = tid >> 3, sub = tid & 7;
      const int cur = (q0 + q) >> 6;
      unsigned mask = 1u | (1u << cur);
      if (cur >= 1) mask |= (1u << (cur - 1));
      int nsel = __popc(mask);
      float cv[4];
  #pragma unroll
      for (int i = 0; i < 4; ++i) {
        int j = sub * 4 + i;
        bool cand = (j <= cur) && !((mask >> j) & 1u);
        cv[i] = cand ? sImp[q * 33 + j] : -1.f;
      }
  #pragma unroll 1
      for (int slot = 0; slot < 5; ++slot) {
        float bv = cv[0]; int bi = sub * 4;
  #pragma unroll
        for (int i = 1; i < 4; ++i) if (cv[i] > bv) { bv = cv[i]; bi = sub * 4 + i; }
  #pragma unroll
        for (int o = 1; o < 8; o <<= 1) {
          float ov = __shfl_xor(bv, o); int oi = __shfl_xor(bi, o);
          if (ov > bv || (ov == bv && oi < bi)) { bv = ov; bi = oi; }
        }
        if (nsel < 8 && bv >= 0.f) {
          mask |= (1u << bi); ++nsel;
  #pragma unroll
          for (int i = 0; i < 4; ++i) if (sub * 4 + i == bi) cv[i] = -1.f;
        }
      }
      if (sub == 0) { sSel[q] = mask; atomicOr(&sSel[32], mask); }
    }
    __syncthreads();

    selq[0] = sSel[l15]; selq[1] = sSel[16 + l15];
    tilemask = sSel[32];

  };
  {
    f32x4 O[2][4];
    float l[2] = {0.f, 0.f};
#pragma unroll
    for (int n = 0; n < 2; ++n)
#pragma unroll
      for (int dt = 0; dt < 4; ++dt) O[n][dt] = f32x4{0.f, 0.f, 0.f, 0.f};
    const u16* vt = P_VT + ((size_t)b * VTC + 512 + g * 64) * SEQ;
    int lo = q0 - 511; if (lo < 0) lo = 0;
    const unsigned allsel[2] = {0xffffffffu, 0xffffffffu};
    int wkb = lo >> 6, wke = kt_end;
    if ((wke - wkb) & 1) { if (wkb > 0) --wkb; else ++wke; }
    flash_pass<false, 1, 2, 2>(hb + C_KW + g * 64, HS, vt, SEQ, wkb, wke, 0u, qf, tq, q0, q0 + 31, slope2[0], 512, allsel, c1, O, l, sK, sVt, sel_hook);
    __syncthreads();
#pragma unroll
    for (int n = 0; n < 2; ++n) {
      float inv = gate[n][2] / l[n];
#pragma unroll
      for (int dt = 0; dt < 4; ++dt) {
        float a0 = Of[n][dt][0] + O[n][dt][0] * inv, a1 = Of[n][dt][1] + O[n][dt][1] * inv;
        float a2 = Of[n][dt][2] + O[n][dt][2] * inv, a3 = Of[n][dt][3] + O[n][dt][3] * inv;
        uint2 o; o.x = pack2(a0, a1); o.y = pack2(a2, a3);
        *(uint2*)(sOf + n * 16 * 72 + dt * 16) = o;
      }
    }
  }
  u32x4 gfin[4];
  {
    f32x4 O[2][4];
    float l[2] = {0.f, 0.f};
#pragma unroll
    for (int n = 0; n < 2; ++n)
#pragma unroll
      for (int dt = 0; dt < 4; ++dt) O[n][dt] = f32x4{0.f, 0.f, 0.f, 0.f};
    const u16* vt = P_VT + ((size_t)b * VTC + 384 + g * 64) * SEQ;
    flash_pass<true, 1, 2>(hb + C_KS + g * 64, HS, vt, SEQ, 0, kt_end, tilemask, qf, tq, q0, q0 + 31, slope2[0], 0x7fffffff, selq, c1, O, l, sK, sVt);
#pragma unroll
    for (int i = 0; i < 4; ++i) {
      const int c = tid + i * 256;
      const int row = c >> 3, ch = c & 7;
      gfin[i] = *(const u32x4*)(P_H + ((size_t)b * SEQ + q0 + (row & 31)) * HS + C_GC + (g * 4 + (row >> 5)) * 64 + ch * 8);
    }
#pragma unroll
    for (int n = 0; n < 2; ++n) {
      float inv = gate[n][1] / l[n];
#pragma unroll
      for (int dt = 0; dt < 4; ++dt) {
        uint2 v = *(const uint2*)(sOf + n * 16 * 72 + dt * 16);
        float a0 = bf2f((u16)(v.x & 0xffff)) + O[n][dt][0] * inv, a1 = bf2f((u16)(v.x >> 16)) + O[n][dt][1] * inv;
        float a2 = bf2f((u16)(v.y & 0xffff)) + O[n][dt][2] * inv, a3 = bf2f((u16)(v.y >> 16)) + O[n][dt][3] * inv;
        uint2 o; o.x = pack2(a0, a1); o.y = pack2(a2, a3);
        *(uint2*)(sOf + n * 16 * 72 + dt * 16) = o;
      }
    }
  }
  __syncthreads();
  {
    const u16* sRow = (const u16*)sImp;
#pragma unroll
    for (int i = 0; i < 4; ++i) {
      const int c = tid + i * 256;
      const int row = c >> 3, ch = c & 7;
      const size_t tok = (size_t)b * SEQ + q0 + (row & 31);
      const int hcol = (g * 4 + (row >> 5)) * 64 + ch * 8;
      u32x4 v = *(const u32x4*)(sRow + row * 72 + ch * 8);
      u32x4 gt = gfin[i];
      u32x4 o;
#pragma unroll
      for (int k = 0; k < 4; ++k) {
        float x0 = bf2f((u16)(v[k] & 0xffff)) * silu_f(bf2f((u16)(gt[k] & 0xffff)));
        float x1 = bf2f((u16)(v[k] >> 16)) * silu_f(bf2f((u16)(gt[k] >> 16)));
        o[k] = pack2(x0, x1);
      }
      *(u32x4*)(P_XN + tok * DM + 512 + hcol) = o;
    }
  }
}

__device__ void phase_x(const Params& p, int layer, unsigned char* smem) {
  constexpr int NA = 8 * 4 * 32, NC = 2 * 8 * 2 * 8, NBI = 8 * 2 * 32;
  const int G = gridDim.x;
  for (int i = blockIdx.x; i < NA / 2; i += G) {
#pragma unroll 1
    for (int h = 0; h < 2; ++h) {
      int it = h ? (NA - 1 - i) : i;
      int qt = 31 - (it >> 5); int r = it & 31; int b = r >> 2, hd = r & 3;
      item_diff(p, layer, b, hd, qt, smem);
    }
  }
  for (int i = blockIdx.x; i < NC; i += G) {
    int t = i; int ct = t & 7; t >>= 3; int g = t & 1; t >>= 1; int b = t & 7; int kv = t >> 3;
    item_compress(p, layer, kv, b, g, ct, smem);
  }
  {
    const int nfree = G - NC;
    int i0, step;
    if (nfree >= 64) { i0 = (int)blockIdx.x - NC; step = nfree; if (i0 < 0) i0 = NBI; }
    else { i0 = blockIdx.x; step = G; }
    for (int i = i0; i < NBI; i += step) {
      int t = i; int qt = t & 31; t >>= 5; int g = t & 1; int b = t >> 1;
      item_swa(p, layer, b, g, qt, smem);
    }
  }
}

__device__ void phase_y(const Params& p, int layer, unsigned char* smem) {
  constexpr int NI = 8 * 2 * 64;
  const int G = gridDim.x;
  for (int i = blockIdx.x; i < NI / 2; i += G) {
#pragma unroll 1
    for (int h = 0; h < 2; ++h) {
      int it = h ? (NI - 1 - i) : i;
      int qt = 63 - (it >> 4); int r = it & 15; int b = r >> 1, g = r & 1;
      item_nsa(p, layer, b, g, qt, smem);
    }
  }
}

__device__ void run_phase(const Params& p, int ph, unsigned char* smem) {
  if (ph == 0) { phase_setup(p, smem); phase_rmsnorm<0>(p.x, p.norm_w, P_XN, nullptr); return; }
  if (ph == NPH - 1) { phase_rmsnorm<1>(p.out, p.final_norm, nullptr, p.out); return; }
  const int layer = (ph - 1) / 5, sub = (ph - 1) % 5;
  switch (sub) {
    case 0: phase_rmsnorm<0>(p.out, p.norm_w + layer * DM, P_XN, nullptr); break;
    case 1: phase_inproj(p, layer, smem); break;
    case 2: phase_x(p, layer, smem); break;
    case 3: phase_y(p, layer, smem); break;
    default: phase_outproj(p, layer, smem); break;
  }
}

#define XB_TMO      128
#define XB_XCNT(j)  (256  + 64 * (j))
#define XB_XSUB(j)  (1280 + 64 * (j))
#define XB_XGEN(j)  (2304 + 64 * (j))
#define XB_TOP      3328
#define XB_TOPGEN   3392
#define XCD_BAR_WORDS 3456
#define XB_SPIN_CAP (1u << 18)
#define LAS __attribute__((address_space(3)))

__device__ __forceinline__ unsigned xb_ld(unsigned* p)              { return __hip_atomic_load(p, __ATOMIC_RELAXED, __HIP_MEMORY_SCOPE_AGENT); }
__device__ __forceinline__ unsigned xb_add(unsigned* p, unsigned v) { return __hip_atomic_fetch_add(p, v, __ATOMIC_RELAXED, __HIP_MEMORY_SCOPE_AGENT); }
__device__ __forceinline__ unsigned xb_xcc_id() { return (unsigned)__builtin_amdgcn_s_getreg((3 << 11) | 20) & 0xFu; }
#define XB_SPIN(cond, bar) do { unsigned _sp = 0; while (cond) { __builtin_amdgcn_s_sleep(1); \
    if ((++_sp & 255u) == 0u) { if (xb_ld(&(bar)[XB_TMO])) break; if (_sp > XB_SPIN_CAP) { atomicAdd(&(bar)[XB_TMO], 1u); break; } } } } while (0)

struct XcdBarrier {
    unsigned* bar; unsigned x;
    volatile LAS unsigned* st;
};

__device__ __forceinline__ XcdBarrier xcd_barrier_post(unsigned* bar, volatile LAS unsigned* st) {
    XcdBarrier b; b.bar = bar; b.x = xb_xcc_id(); b.st = st;
    if (threadIdx.x == 0) (void)xb_add(&bar[XB_XCNT(b.x)], 1u);
    return b;
}
__device__ __forceinline__ void xcd_barrier_complete(unsigned* bar, unsigned x, unsigned& nloc, unsigned& nx) {
    const unsigned G = gridDim.x * gridDim.y * gridDim.z;
    unsigned sum, cnt, mine, sp = 0u;
    for (;;) {
        sum = 0u; cnt = 0u; mine = 0u;
#pragma unroll
        for (unsigned j = 0; j < 16; ++j) { const unsigned c = xb_ld(&bar[XB_XCNT(j)]); sum += c; cnt += (c > 0u) ? 1u : 0u; mine = (j == x) ? c : mine; }
        if (sum == G) break;
        __builtin_amdgcn_s_sleep(1);
        if ((++sp & 255u) == 0u) { if (xb_ld(&bar[XB_TMO])) break; if (sp > XB_SPIN_CAP) { atomicAdd(&bar[XB_TMO], 1u); break; } }
    }
    nloc = mine > 0u ? mine : 1u; nx = cnt > 0u ? cnt : 1u;
}

__device__ __forceinline__ void xcd_barrier(const XcdBarrier& b) {
    asm volatile("s_waitcnt vmcnt(0)" ::: "memory");
    __syncthreads();
    if (threadIdx.x == 0) {
        unsigned* bar = b.bar;
        __builtin_amdgcn_s_waitcnt(0);
        unsigned nloc = b.st[0], nx = b.st[1];
        if (nloc == 0u) { xcd_barrier_complete(bar, b.x, nloc, nx); b.st[0] = nloc; b.st[1] = nx; }
        const unsigned old = xb_add(&bar[XB_XSUB(b.x)], 1u);
        const unsigned gen = old / nloc;
        if (old + 1u == (gen + 1u) * nloc) {
            __builtin_amdgcn_fence(__ATOMIC_RELEASE, "agent");
            asm volatile("s_waitcnt vmcnt(0)" ::: "memory");
            const unsigned og = xb_add(&bar[XB_TOP], 1u);
            const unsigned tg = og / nx;
            if (og + 1u == (tg + 1u) * nx) xb_add(&bar[XB_TOPGEN], 1u);
            else XB_SPIN(xb_ld(&bar[XB_TOPGEN]) == tg, bar);
            __builtin_amdgcn_fence(__ATOMIC_ACQUIRE, "agent");
            xb_add(&bar[XB_XGEN(b.x)], 1u);
            asm volatile("s_waitcnt vmcnt(0)" ::: "memory");
        } else {
            XB_SPIN(xb_ld(&bar[XB_XGEN(b.x)]) == gen, bar);
            __builtin_amdgcn_fence(__ATOMIC_ACQUIRE, "agent");
            asm volatile("s_waitcnt vmcnt(0)" ::: "memory");
        }
    }
    __syncthreads();
}


__global__ void __launch_bounds__(256, 2) hybrid_megakernel(Params p, int ph_lo, int ph_hi) {
  __shared__ __attribute__((aligned(16))) unsigned char smem[SM_TOTAL];
  __shared__ uint4 xb_words;
  if (threadIdx.x == 0) xb_words = make_uint4(0u, 0u, 0u, 0u);
  __syncthreads();
  XcdBarrier xb = xcd_barrier_post((unsigned*)P_CTR, (volatile LAS unsigned*)&xb_words);
  for (int ph = ph_lo; ph < ph_hi; ++ph) {
    if (ph == 1) continue;
    run_phase(p, ph, smem);
    if (ph + 1 < ph_hi) {
      if (ph_hi > 1000) cg::this_grid().sync();
      xcd_barrier(xb);
    }
  }
}

static inline size_t align_up(size_t v) { return (v + 255) & ~(size_t)255; }

extern "C" void kernel_launch(void* const* d_in, const int* in_sizes, int n_in, void* d_out, int out_size,
                              void* d_ws, size_t ws_size, hipStream_t stream) {
  Params p{};
  p.x = (const float*)d_in[0]; p.norm_w = (const float*)d_in[1]; p.w_in = (const float*)d_in[2];
  p.w_out = (const float*)d_in[3]; p.lq1 = (const float*)d_in[4]; p.lk1 = (const float*)d_in[5];
  p.lq2 = (const float*)d_in[6]; p.lk2 = (const float*)d_in[7]; p.subln = (const float*)d_in[8];
  p.sinks = (const float*)d_in[9]; p.pe_k = (const float*)d_in[10]; p.pe_v = (const float*)d_in[11];
  p.wk1 = (const float*)d_in[12]; p.wk2 = (const float*)d_in[13]; p.wv1 = (const float*)d_in[14];
  p.wv2 = (const float*)d_in[15]; p.final_norm = (const float*)d_in[16];
  p.out = (float*)d_out;
  p.ws = (unsigned char*)d_ws;
  if (WS_NEED > ws_size) fprintf(stderr, "workspace too small: need %zu have %zu\n", (size_t)WS_NEED, ws_size);
  (void)hipMemsetAsync(p.ws + OFF_CTR, 0, 16384, stream);
  static int grid_blocks = 0;
  if (!grid_blocks) {
    int dev = 0, cus = 0, per_cu = 0;
    hipGetDevice(&dev);
    hipDeviceGetAttribute(&cus, hipDeviceAttributeMultiprocessorCount, dev);
    hipOccupancyMaxActiveBlocksPerMultiprocessor(&per_cu, hybrid_megakernel, 256, 0);
    if (per_cu > 2) per_cu = 2;
    if (per_cu < 1) per_cu = 1;
    grid_blocks = (cus * per_cu) & ~15;
  }
#if MULTI_LAUNCH
  for (int ph = 0; ph < NPH; ++ph) {
    if (ph == 1) continue;
    int lo = ph, hi = ph + 1;
    hipLaunchKernelGGL(hybrid_megakernel, dim3(grid_blocks), dim3(256), 0, stream, p, lo, hi);
  }
#else
  int lo = 0, hi = NPH;
  void* args[] = {&p, &lo, &hi};
  hipError_t e = hipLaunchCooperativeKernel((void*)hybrid_megakernel, dim3(grid_blocks), dim3(256), args, 0, stream);
  if (e != hipSuccess) fprintf(stderr, "cooperative launch failed: %s (grid %d)\n", hipGetErrorString(e), grid_blocks);
#endif
}
```

```cpp
#include <hip/hip_runtime.h>
#include <hip/hip_cooperative_groups.h>
#include <cstdio>
namespace cg = cooperative_groups;

#ifndef MULTI_LAUNCH
#define MULTI_LAUNCH 0
#endif

typedef unsigned short u16;
typedef __attribute__((ext_vector_type(8))) short bf16x8;
typedef __attribute__((ext_vector_type(4))) float f32x4;
typedef __attribute__((ext_vector_type(4))) unsigned u32x4;

constexpr int NBATCH = 8, SEQ = 2048, TOK = NBATCH * SEQ, DM = 1024, DEPTH = 4;
constexpr int INC = 3608;
constexpr int HS = 3712;
constexpr int NT_IN = HS / 128;
constexpr int VTC = 640;
constexpr float LOG2E = 1.4426950408889634f;
constexpr int NPH = 2 + 5 * DEPTH;

constexpr int C_QA = 0, C_KA = 256, C_VA = 512, C_GA = 768, C_QB = 1024, C_KB = 1280, C_VB = 1408, C_GB = 1536,
              C_QC = 1792, C_KC = 2304, C_VC = 2432, C_KS = 2560, C_VS = 2688, C_KW = 2816, C_VW = 2944,
              C_GL = 3072, C_GC = 3096;

struct Params {
  const float* x; const float* norm_w; const float* w_in; const float* w_out;
  const float* lq1; const float* lk1; const float* lq2; const float* lk2;
  const float* subln; const float* sinks; const float* pe_k; const float* pe_v;
  const float* wk1; const float* wk2; const float* wv1; const float* wv2; const float* final_norm;
  float* out;
  unsigned char* ws;
};


constexpr size_t AL(size_t v) { return (v + 255) & ~(size_t)255; }
constexpr size_t OFF_CTR = 0;
constexpr size_t OFF_LAM = 16384;
constexpr size_t OFF_WIN = OFF_LAM + 1024;
constexpr size_t OFF_WOUT = AL(OFF_WIN + (size_t)DEPTH * HS * DM * 2);
constexpr size_t OFF_WK1 = AL(OFF_WOUT + (size_t)DEPTH * DM * DM * 2);
constexpr size_t OFF_WV1 = AL(OFF_WK1 + (size_t)DEPTH * 128 * 2048 * 2);
constexpr size_t OFF_WK2 = AL(OFF_WV1 + (size_t)DEPTH * 128 * 2048 * 2);
constexpr size_t OFF_WV2 = AL(OFF_WK2 + (size_t)DEPTH * 64 * 128 * 2);
constexpr size_t OFF_XN = AL(OFF_WV2 + (size_t)DEPTH * 64 * 128 * 2);
constexpr size_t OFF_H = AL(OFF_XN + (size_t)TOK * DM * 2);
constexpr size_t OFF_VT = AL(OFF_H + (size_t)TOK * HS * 2);
constexpr size_t OFF_KCMP = AL(OFF_VT + (size_t)NBATCH * VTC * SEQ * 2);
constexpr size_t OFF_VCMP = AL(OFF_KCMP + (size_t)NBATCH * 2 * 128 * 64 * 2);
constexpr size_t WS_NEED = AL(OFF_VCMP + (size_t)NBATCH * 2 * 64 * 128 * 2);
#define P_CTR ((int*)(p.ws + OFF_CTR))
#define P_LAM ((float*)(p.ws + OFF_LAM))
#define P_WIN_T ((u16*)(p.ws + OFF_WIN))
#define P_WOUT_T ((u16*)(p.ws + OFF_WOUT))
#define P_WK1_T ((u16*)(p.ws + OFF_WK1))
#define P_WV1_T ((u16*)(p.ws + OFF_WV1))
#define P_WK2_T ((u16*)(p.ws + OFF_WK2))
#define P_WV2_T ((u16*)(p.ws + OFF_WV2))
#define P_XN ((u16*)(p.ws + OFF_XN))
#define P_H ((u16*)(p.ws + OFF_H))
#define P_VT ((u16*)(p.ws + OFF_VT))
#define P_KCMP ((u16*)(p.ws + OFF_KCMP))
#define P_VCMP_T ((u16*)(p.ws + OFF_VCMP))

__device__ __forceinline__ int otid() { int t = threadIdx.x; asm volatile("" : "+v"(t)); return t; }
__device__ __forceinline__ float bf2f(u16 b) { return __uint_as_float(((unsigned)b) << 16); }
typedef __attribute__((ext_vector_type(2))) float f32x2;
typedef __attribute__((ext_vector_type(2))) __bf16 bf16x2_t;
__device__ __forceinline__ unsigned pack2(float lo, float hi) {
  f32x2 v = {lo, hi};
  bf16x2_t b = __builtin_convertvector(v, bf16x2_t);
  return __builtin_bit_cast(unsigned, b);
}
__device__ __forceinline__ bf16x8 pack8(float a0, float a1, float a2, float a3, float a4, float a5, float a6, float a7) {
  u32x4 u;
  u[0] = pack2(a0, a1); u[1] = pack2(a2, a3); u[2] = pack2(a4, a5); u[3] = pack2(a6, a7);
  return __builtin_bit_cast(bf16x8, u);
}
__device__ __forceinline__ f32x4 mfma16(bf16x8 a, bf16x8 b, f32x4 c) {
  return __builtin_amdgcn_mfma_f32_16x16x32_bf16(a, b, c, 0, 0, 0);
}
__device__ __forceinline__ float fexp2(float x) { return __builtin_amdgcn_exp2f(x); }
__device__ __forceinline__ float silu_f(float x) { return x * __builtin_amdgcn_rcpf(1.f + __expf(-x)); }
__device__ __forceinline__ float sigmoid_f(float x) { return __builtin_amdgcn_rcpf(1.f + __expf(-x)); }
__device__ __forceinline__ float quad_max(float v) {
  v = fmaxf(v, __shfl_xor(v, 16)); v = fmaxf(v, __shfl_xor(v, 32)); return v;
}
__device__ __forceinline__ float quad_sum(float v) {
  v += __shfl_xor(v, 16); v += __shfl_xor(v, 32); return v;
}

constexpr int SM_MAIN = 73728;
constexpr int SM_IMP = 4 * 32 * 33 * 4;
constexpr int SM_IMP_OFF = 36864;
constexpr int SM_TOTAL = SM_MAIN + 256;

struct TItem { const float* src; u16* dst; int K, N, k0, n0; };
__device__ __forceinline__ TItem setup_item(const Params& p, int it) {
  const int n_win = DEPTH * 16 * 58;
  const int n_wout = DEPTH * 16 * 16;
  const int n_w1 = DEPTH * 32 * 2;
  const int n_w2 = DEPTH * 2 * 1;
  TItem t;
  int i = it;
  if (i < n_win) {
    int l = i / (16 * 58); int r = i % (16 * 58); int nt = r / 16, kt = r % 16;
    t.src = p.w_in + (size_t)l * DM * INC; t.dst = P_WIN_T + (size_t)l * HS * DM; t.K = DM; t.N = INC; t.k0 = kt * 64; t.n0 = nt * 64;
    return t;
  }
  i -= n_win;
  if (i < n_wout) {
    int l = i / 256; int r = i % 256; int nt = r / 16, kt = r % 16;
    t.src = p.w_out + (size_t)l * DM * DM; t.dst = P_WOUT_T + (size_t)l * DM * DM; t.K = DM; t.N = DM; t.k0 = kt * 64; t.n0 = nt * 64;
    return t;
  }
  i -= n_wout;
  if (i < 2 * n_w1) {
    int which = i / n_w1; int r = i % n_w1; int l = r / 64; r %= 64; int nt = r / 32, kt = r % 32;
    t.src = (which ? p.wv1 : p.wk1) + (size_t)l * 2048 * 128; t.dst = (which ? P_WV1_T : P_WK1_T) + (size_t)l * 128 * 2048;
    t.K = 2048; t.N = 128; t.k0 = kt * 64; t.n0 = nt * 64;
    return t;
  }
  i -= 2 * n_w1;
  {
    int which = i / n_w2; int r = i % n_w2; int l = r / 2; int kt = r % 2;
    t.src = (which ? p.wv2 : p.wk2) + (size_t)l * 128 * 64; t.dst = (which ? P_WV2_T : P_WK2_T) + (size_t)l * 64 * 128;
    t.K = 128; t.N = 64; t.k0 = kt * 64; t.n0 = 0;
  }
  return t;
}

__device__ void phase_setup(const Params& p, unsigned char* smem) {
  float* tile = (float*)smem;
  const int total = DEPTH * 16 * 58 + DEPTH * 16 * 16 + 2 * DEPTH * 32 * 2 + 2 * DEPTH * 2;
  const int tid = otid();
  const int tx = tid & 63, ty = tid >> 6;
  const int nl = tid >> 2, kc = (tid & 3) * 16;
  const int G = gridDim.x;
  int it = blockIdx.x;
  TItem cur, nxt, nx2;
  float vals[16], nvals[16], nvals2[16];
  if (it < total) {
    cur = setup_item(p, it);
#pragma unroll
    for (int i = 0; i < 16; ++i) {
      int n = cur.n0 + tx;
      vals[i] = (n < cur.N) ? cur.src[(size_t)(cur.k0 + ty + 4 * i) * cur.N + n] : 0.f;
    }
  }
  if (it + G < total) {
    nxt = setup_item(p, it + G);
#pragma unroll
    for (int i = 0; i < 16; ++i) {
      int n = nxt.n0 + tx;
      nvals[i] = (n < nxt.N) ? nxt.src[(size_t)(nxt.k0 + ty + 4 * i) * nxt.N + n] : 0.f;
    }
  }
  while (it < total) {
    const int nit = it + G;
    const int nit2 = it + 2 * G;
    if (nit2 < total) {
      nx2 = setup_item(p, nit2);
#pragma unroll
      for (int i = 0; i < 16; ++i) {
        int n = nx2.n0 + tx;
        nvals2[i] = (n < nx2.N) ? nx2.src[(size_t)(nx2.k0 + ty + 4 * i) * nx2.N + n] : 0.f;
      }
    }
    __syncthreads();
#pragma unroll
    for (int i = 0; i < 16; ++i) tile[(ty + 4 * i) * 65 + tx] = vals[i];
    __syncthreads();
    u32x4 a, b;
#pragma unroll
    for (int j = 0; j < 4; ++j) {
      a[j] = pack2(tile[(kc + 2 * j) * 65 + nl], tile[(kc + 2 * j + 1) * 65 + nl]);
      b[j] = pack2(tile[(kc + 8 + 2 * j) * 65 + nl], tile[(kc + 8 + 2 * j + 1) * 65 + nl]);
    }
    u16* d = cur.dst + (size_t)(cur.n0 + nl) * cur.K + cur.k0 + kc;
    *(u32x4*)d = a;
    *(u32x4*)(d + 8) = b;
#pragma unroll
    for (int i = 0; i < 16; ++i) { vals[i] = nvals[i]; nvals[i] = nvals2[i]; }
    cur = nxt; nxt = nx2;
    it = nit;
  }
  const int lt_ = otid();
  if (blockIdx.x == 0 && lt_ < DEPTH) {
    int l = lt_;
    float s1 = 0.f, s2 = 0.f;
    for (int i = 0; i < 32; ++i) {
      s1 += p.lq1[l * 32 + i] * p.lk1[l * 32 + i];
      s2 += p.lq2[l * 32 + i] * p.lk2[l * 32 + i];
    }
    float lam_init = 0.8f - 0.6f * expf(-0.3f * (float)l);
    P_LAM[l] = expf(s1) - expf(s2) + lam_init;
  }
}

template <int MODE>
__device__ void phase_rmsnorm(const float* src, const float* __restrict__ w, u16* __restrict__ dstb, float* dstf) {
  const int tid_ = otid();
  const int lane = tid_ & 63;
  const int gw = blockIdx.x * 4 + (tid_ >> 6);
  const int nw = gridDim.x * 4;
  float4 ww[4];
#pragma unroll
  for (int i = 0; i < 4; ++i) ww[i] = *(const float4*)(w + (i * 64 + lane) * 4);
  float4 v[4], nv[4];
  int row = gw;
  if (row < TOK) {
#pragma unroll
    for (int i = 0; i < 4; ++i) v[i] = *(const float4*)(src + (size_t)row * DM + (i * 64 + lane) * 4);
  }
  while (row < TOK) {
    const int nrow = row + nw;
    if (nrow < TOK) {
#pragma unroll
      for (int i = 0; i < 4; ++i) nv[i] = *(const float4*)(src + (size_t)nrow * DM + (i * 64 + lane) * 4);
    }
    float ss = 0.f;
#pragma unroll
    for (int i = 0; i < 4; ++i) ss += v[i].x * v[i].x + v[i].y * v[i].y + v[i].z * v[i].z + v[i].w * v[i].w;
#pragma unroll
    for (int o = 1; o < 64; o <<= 1) ss += __shfl_xor(ss, o);
    float rstd = rsqrtf(ss * (1.f / DM) + 1e-6f);
#pragma unroll
    for (int i = 0; i < 4; ++i) {
      int c = (i * 64 + lane) * 4;
      float a0 = v[i].x * rstd * ww[i].x, a1 = v[i].y * rstd * ww[i].y, a2 = v[i].z * rstd * ww[i].z, a3 = v[i].w * rstd * ww[i].w;
      if (MODE == 0) {
        uint2 o2; o2.x = pack2(a0, a1); o2.y = pack2(a2, a3);
        *(uint2*)(dstb + (size_t)row * DM + c) = o2;
      } else {
        float4 o4; o4.x = a0; o4.y = a1; o4.z = a2; o4.w = a3;
        *(float4*)(dstf + (size_t)row * DM + c) = o4;
      }
    }
#pragma unroll
    for (int i = 0; i < 4; ++i) v[i] = nv[i];
    row = nrow;
  }
}

constexpr int G2S = 32;
constexpr int G2STAGE = (256 + 128) * G2S;
template <int MODE>
__device__ void gemm_tile2(const u16* __restrict__ X, int lda, const u16* __restrict__ W, int ldb, int K,
                           int m0, int n0, u16* __restrict__ outb, int vbase,
                           const float* resid, float* outf, unsigned char* smem) {
  u16* sbase = (u16*)smem;
  const int tid = otid(), lane = tid & 63, l15 = lane & 15, quad = lane >> 4;
  const int wave = tid >> 6;
  const int wx = wave >> 1, ww = wave & 1;
  f32x4 acc[8][4];
#pragma unroll
  for (int i = 0; i < 8; ++i)
#pragma unroll
    for (int j = 0; j < 4; ++j) acc[i][j] = f32x4{0.f, 0.f, 0.f, 0.f};
  u32x4 rx[2][4], rw[2][2];
  const int lrow = tid >> 2, lkc = (tid & 3) * 8;
  const int lsw = ((tid & 3) ^ ((0 - (lrow >> 2)) & 3)) * 8;
  const int fsw = (quad ^ ((0 - (l15 >> 2)) & 3)) * 8;
  const auto rsX = __builtin_amdgcn_make_buffer_rsrc((void*)(X + (size_t)m0 * lda), (short)0, 0x7fffffff, 0x00020000);
  const auto rsW = __builtin_amdgcn_make_buffer_rsrc((void*)(W + (size_t)n0 * ldb), (short)0, 0x7fffffff, 0x00020000);
  const int vox = (lrow * lda + lkc) * 2, vow = (lrow * ldb + lkc) * 2;
  const int nk = K / 32;
#define G2_GLOAD(S_, KT_)                                                                                      \
  {                                                                                                            \
    _Pragma("unroll") for (int i = 0; i < 4; ++i)                                                              \
      rx[S_][i] = __builtin_amdgcn_raw_buffer_load_b128(rsX, vox, i * 64 * lda * 2 + (KT_) * 64, 0);           \
    _Pragma("unroll") for (int i = 0; i < 2; ++i)                                                              \
      rw[S_][i] = __builtin_amdgcn_raw_buffer_load_b128(rsW, vow, i * 64 * ldb * 2 + (KT_) * 64, 0);           \
  }
#define G2_LSTORE(S_, ST_)                                                                                     \
  {                                                                                                            \
    u16* s_ = sbase + (ST_) * G2STAGE;                                                                         \
    _Pragma("unroll") for (int i = 0; i < 4; ++i) *(u32x4*)(s_ + (lrow + i * 64) * G2S + lsw) = rx[S_][i];     \
    _Pragma("unroll") for (int i = 0; i < 2; ++i) *(u32x4*)(s_ + 256 * G2S + (lrow + i * 64) * G2S + lsw) = rw[S_][i]; \
  }
  G2_GLOAD(0, 0);
  G2_GLOAD(1, 1);
  __syncthreads();
  G2_LSTORE(0, 0);
  G2_GLOAD(0, 2);
  __syncthreads();
  for (int kt2 = 0; kt2 < nk; kt2 += 2) {
#pragma unroll
    for (int h = 0; h < 2; ++h) {
      const int kt = kt2 + h;
      const u16* st = sbase + h * G2STAGE;
      bf16x8 fw[4], fx[4];
#pragma unroll
      for (int j = 0; j < 4; ++j) fw[j] = *(const bf16x8*)(st + 256 * G2S + (ww * 64 + j * 16 + l15) * G2S + fsw);
#pragma unroll
      for (int i = 0; i < 4; ++i) fx[i] = *(const bf16x8*)(st + (wx * 128 + i * 16 + l15) * G2S + fsw);
      __builtin_amdgcn_sched_barrier(0);
      __builtin_amdgcn_s_setprio(1);
#pragma unroll
      for (int i = 0; i < 4; ++i) {
#pragma unroll
        for (int j = 0; j < 4; ++j) {
          if (MODE == 1) acc[i][j] = mfma16(fx[i], fw[j], acc[i][j]);
          else acc[i][j] = mfma16(fw[j], fx[i], acc[i][j]);
        }
      }
      __builtin_amdgcn_s_setprio(0);
      __builtin_amdgcn_sched_barrier(0);
#pragma unroll
      for (int i = 0; i < 4; ++i) fx[i] = *(const bf16x8*)(st + (wx * 128 + (i + 4) * 16 + l15) * G2S + fsw);
      __builtin_amdgcn_sched_barrier(0);
      if (kt + 1 < nk) G2_LSTORE(1 - h, 1 - h);
      if (kt + 3 < nk) G2_GLOAD(1 - h, kt + 3);
      __builtin_amdgcn_sched_barrier(0);
      __builtin_amdgcn_s_setprio(1);
#pragma unroll
      for (int i = 0; i < 4; ++i) {
#pragma unroll
        for (int j = 0; j < 4; ++j) {
          if (MODE == 1) acc[i + 4][j] = mfma16(fx[i], fw[j], acc[i + 4][j]);
          else acc[i + 4][j] = mfma16(fw[j], fx[i], acc[i + 4][j]);
        }
      }
      __builtin_amdgcn_s_setprio(0);
      __syncthreads();
    }
  }
#undef G2_GLOAD
#undef G2_LSTORE
  if (MODE == 0) {
    u16* sT = (u16*)smem;
#pragma unroll
    for (int i = 0; i < 8; ++i)
#pragma unroll
      for (int j = 0; j < 4; ++j) {
        f32x4 a = acc[i][j];
        uint2 o; o.x = pack2(a[0], a[1]); o.y = pack2(a[2], a[3]);
        *(uint2*)(sT + (wx * 128 + i * 16 + l15) * 136 + ww * 64 + j * 16 + quad * 4) = o;
      }
    __syncthreads();
    const int ch = tid & 15, r0 = tid >> 4;
#pragma unroll
    for (int ps = 0; ps < 16; ++ps) {
      int row = ps * 16 + r0;
      u32x4 v = *(const u32x4*)(sT + row * 136 + ch * 8);
      *(u32x4*)(outb + (size_t)(m0 + row) * HS + n0 + ch * 8) = v;
    }
  } else if (MODE == 1) {
    u16* sT = (u16*)smem;
#pragma unroll
    for (int i = 0; i < 8; ++i)
#pragma unroll
      for (int j = 0; j < 4; ++j) {
        f32x4 a = acc[i][j];
        uint2 o; o.x = pack2(a[0], a[1]); o.y = pack2(a[2], a[3]);
        *(uint2*)(sT + (ww * 64 + j * 16 + l15) * 264 + wx * 128 + i * 16 + quad * 4) = o;
      }
    __syncthreads();
    const int ch = tid & 31, r0 = tid >> 5;
    const int b = m0 >> 11, s0 = m0 & 2047;
#pragma unroll
    for (int ps = 0; ps < 16; ++ps) {
      int row = ps * 8 + r0;
      u32x4 v = *(const u32x4*)(sT + row * 264 + ch * 8);
      *(u32x4*)(outb + ((size_t)(b * VTC + vbase + row)) * SEQ + s0 + ch * 8) = v;
    }
  } else {
    float* sT = (float*)smem;
    const int ch = tid & 31, r0 = tid >> 5;
#pragma unroll
    for (int half = 0; half < 2; ++half) {
      if (half) __syncthreads();
      if (wx == half) {
#pragma unroll
        for (int i = 0; i < 8; ++i)
#pragma unroll
          for (int j = 0; j < 4; ++j)
            *(f32x4*)(sT + (i * 16 + l15) * 132 + ww * 64 + j * 16 + quad * 4) = acc[i][j];
      }
      __syncthreads();
#pragma unroll
      for (int ps = 0; ps < 16; ++ps) {
        int row = ps * 8 + r0;
        f32x4 v = *(const f32x4*)(sT + row * 132 + ch * 4);
        size_t off = (size_t)(m0 + half * 128 + row) * DM + n0 + ch * 4;
        f32x4 r4 = *(const f32x4*)(resid + off);
        *(f32x4*)(outf + off) = r4 + v;
      }
    }
  }
}

__device__ void phase_inproj(const Params& p, int layer, unsigned char* smem) {
  const u16* W = P_WIN_T + (size_t)layer * HS * DM;
  const int xcd = blockIdx.x & 7, loc = blockIdx.x >> 3, nloc = gridDim.x >> 3;
  for (int idx = loc; idx < 8 * NT_IN; idx += nloc) {
    int grp = idx / (4 * NT_IN), within = idx % (4 * NT_IN);
    int nt = within >> 2, mt = xcd * 8 + grp * 4 + (within & 3);
    int vbase = -1;
    if (nt == 4) vbase = 0; else if (nt == 5) vbase = 128; else if (nt == 11) vbase = 256;
    else if (nt == 21) vbase = 384; else if (nt == 23) vbase = 512;
    if (vbase >= 0) gemm_tile2<1>(P_XN, DM, W, DM, DM, mt * 256, nt * 128, P_VT, vbase, nullptr, nullptr, smem);
    else gemm_tile2<0>(P_XN, DM, W, DM, DM, mt * 256, nt * 128, P_H, 0, nullptr, nullptr, smem);
  }
}

__device__ void phase_outproj(const Params& p, int layer, unsigned char* smem) {
  const u16* W = P_WOUT_T + (size_t)layer * DM * DM;
  const float* resid = (layer == 0) ? p.x : p.out;
  const int xcd = blockIdx.x & 7, loc = blockIdx.x >> 3, nloc = gridDim.x >> 3;
  for (int idx = loc; idx < 8 * 8; idx += nloc) {
    int nt = idx >> 3, mt = xcd * 8 + (idx & 7);
    gemm_tile2<2>(P_XN, DM, W, DM, DM, mt * 256, nt * 128, nullptr, 0, resid, p.out, smem);
  }
}

template <bool MASKED>
__device__ __forceinline__ void sm_step(f32x4 (&S)[4], float c1, float slope2, float tb, int kbase, int tqn,
                                        int window, bool selok, bf16x8 (&pb)[2]) {
#pragma unroll
  for (int mt = 0; mt < 4; ++mt)
#pragma unroll
    for (int r = 0; r < 4; ++r) {
      float u = fmaf(slope2, (float)(mt * 16 + r), fmaf(S[mt][r], c1, tb));
      if (MASKED) {
        int dist = tqn - (kbase + mt * 16 + r);
        bool valid = (dist >= 0) && (dist < window) && selok;
        u = valid ? u : -1e30f;
      }
      S[mt][r] = fexp2(u);
    }
#pragma unroll
  for (int k2 = 0; k2 < 2; ++k2)
    pb[k2] = pack8(S[2 * k2][0], S[2 * k2][1], S[2 * k2][2], S[2 * k2][3],
                   S[2 * k2 + 1][0], S[2 * k2 + 1][1], S[2 * k2 + 1][2], S[2 * k2 + 1][3]);
}

__device__ __forceinline__ bf16x8 vt_frag(const u16* sVt, int dt, int k2, int l15, int quad) {
  const u16* vp = sVt + (dt * 16 + l15) * 72 + k2 * 32 + quad * 4;
  uint2 lo = *(const uint2*)vp;
  uint2 hi = *(const uint2*)(vp + 16);
  u32x4 u; u[0] = lo.x; u[1] = lo.y; u[2] = hi.x; u[3] = hi.y;
  return __builtin_bit_cast(bf16x8, u);
}

struct NoHook { __device__ __forceinline__ void operator()() const {} };
template <bool SEL, int NMAP, int NQ, int TK = 1, class HOOK = NoHook>
__device__ __forceinline__ void flash_pass(const u16* __restrict__ Kg, int kstride, const u16* __restrict__ Vtg, int vtstride,
                                           int kt_begin, int kt_end, unsigned tilemask,
                                           const bf16x8 (&qf)[NQ][2], const int (&tq)[NQ], int qlo, int qhi,
                                           float slope2, int window, const unsigned (&selq)[NQ], float c1,
                                           f32x4 (&O)[NQ * NMAP][4], float (&l)[NQ * NMAP], u16* sK, u16* sVt,
                                           HOOK hook = HOOK()) {
  const int tid = otid(), lane = tid & 63, l15 = lane & 15, quad = lane >> 4;
  const int lrow = tid >> 3, lkc = (tid & 7) * 8;
  const u16* gk = Kg + (size_t)lrow * kstride + lkc;
  const u16* gv = Vtg + (size_t)lrow * vtstride + lkc;
  constexpr int TSZ = 2 * 64 * 72;
  constexpr int FST = TK * TSZ;
  u16* wk = sK + lrow * 64 + ((tid & 7) ^ ((lrow >> 1) & 7)) * 8;
  u16* wv = sK + 64 * 72 + lrow * 72 + lkc;
  int kt = kt_begin;
  if (SEL) {
    unsigned rem = tilemask >> kt;
    kt = rem ? kt + __ffs(rem) - 1 : kt_end;
  }
  auto next_tile = [&](int k) -> int {
    if (!SEL) return k + TK;
    unsigned rem = (k + 1 < 32) ? (tilemask >> (k + 1)) : 0u;
    return rem ? k + 1 + __ffs(rem) - 1 : kt_end;
  };
  u32x4 rk[TK][2], rv[TK][2];
  auto gload = [&](int k) {
#pragma unroll
    for (int t = 0; t < TK; ++t)
#pragma unroll
      for (int i = 0; i < 2; ++i) {
        rk[t][i] = *(const u32x4*)(gk + (size_t)((k + t) * 64 + i * 32) * kstride);
        rv[t][i] = *(const u32x4*)(gv + (size_t)(i * 32) * vtstride + (k + t) * 64);
      }
  };
  auto lstore = [&](int st) {
#pragma unroll
    for (int t = 0; t < TK; ++t)
#pragma unroll
      for (int i = 0; i < 2; ++i) {
        *(u32x4*)(wk + st * FST + t * TSZ + i * 32 * 64) = rk[t][i];
        *(u32x4*)(wv + st * FST + t * TSZ + i * 32 * 72) = rv[t][i];
      }
  };
  if (kt >= kt_end) { hook(); return; }
  const bf16x8 ones = bf16x8{0x3F80, 0x3F80, 0x3F80, 0x3F80, 0x3F80, 0x3F80, 0x3F80, 0x3F80};
  f32x4 L[NQ * NMAP];
#pragma unroll
  for (int i = 0; i < NQ * NMAP; ++i) L[i] = f32x4{0.f, 0.f, 0.f, 0.f};
  int nxt = next_tile(kt);
  {
    u32x4 fk[TK][2], fv[TK][2];
#pragma unroll
    for (int t = 0; t < TK; ++t)
#pragma unroll
      for (int i = 0; i < 2; ++i) {
        fk[t][i] = *(const u32x4*)(gk + (size_t)((kt + t) * 64 + i * 32) * kstride);
        fv[t][i] = *(const u32x4*)(gv + (size_t)(i * 32) * vtstride + (kt + t) * 64);
      }
    if (nxt < kt_end) gload(nxt);
    hook();
    __syncthreads();
#pragma unroll
    for (int t = 0; t < TK; ++t)
#pragma unroll
      for (int i = 0; i < 2; ++i) {
        *(u32x4*)(wk + t * TSZ + i * 32 * 64) = fk[t][i];
        *(u32x4*)(wv + t * TSZ + i * 32 * 72) = fv[t][i];
      }
  }
  __syncthreads();
  int stg = 0;
  while (kt < kt_end) {
    const int nxt2 = (nxt < kt_end) ? next_tile(nxt) : kt_end;
    if (nxt < kt_end) lstore(stg ^ 1);
    if (nxt2 < kt_end) gload(nxt2);
#pragma unroll
    for (int hk = 0; hk < TK; ++hk) {
    const u16* cK = sK + stg * FST + hk * TSZ;
    const u16* cV = cK + 64 * 72;
    const int k0 = (kt + hk) * 64;
    if (k0 <= qhi && (qlo - (k0 + 63)) < window) {
      bool full = (k0 + 63 <= qlo) && (qhi - k0 < window);
      const bool rowfull = SEL && full;
      bool selok[NQ];
#pragma unroll
      for (int n = 0; n < NQ; ++n) selok[n] = true;
      if (SEL) {
        bool all = true;
#pragma unroll
        for (int n = 0; n < NQ; ++n) { selok[n] = ((selq[n] >> kt) & 1u) != 0; all = all && selok[n]; }
        full = full && __all(all);
      }
      const int kbase = k0 + quad * 4;
#pragma unroll
      for (int mp = 0; mp < NMAP; ++mp) {
#pragma unroll
        for (int n = 0; n < NQ; ++n) {
          f32x4 S[4];
#pragma unroll
          for (int mt = 0; mt < 4; ++mt) S[mt] = f32x4{0.f, 0.f, 0.f, 0.f};
#pragma unroll
          for (int ks = 0; ks < 2; ++ks) {
            if (NMAP == 2 && ks != mp) continue;
#pragma unroll
            for (int mt = 0; mt < 4; ++mt) {
              bf16x8 a = *(const bf16x8*)(cK + (mt * 16 + l15) * 64 + (((ks * 4 + quad) ^ ((l15 >> 1) & 7)) * 8));
              S[mt] = mfma16(a, qf[n][ks], S[mt]);
            }
          }
          bf16x8 pb[2];
          const float tb = slope2 * (float)(kbase - tq[n]);
          if (full || rowfull) {
            sm_step<false>(S, c1, slope2, tb, kbase, tq[n], window, true, pb);
            if (SEL && !full && !selok[n]) {
              pb[0] = bf16x8{0, 0, 0, 0, 0, 0, 0, 0}; pb[1] = bf16x8{0, 0, 0, 0, 0, 0, 0, 0};
            }
          } else sm_step<true>(S, c1, slope2, tb, kbase, tq[n], window, selok[n], pb);
#pragma unroll
          for (int k2 = 0; k2 < 2; ++k2) {
#pragma unroll
            for (int dt = 0; dt < 4; ++dt) {
              bf16x8 a = vt_frag(cV, dt, k2, l15, quad);
              O[mp * NQ + n][dt] = mfma16(a, pb[k2], O[mp * NQ + n][dt]);
            }
            L[mp * NQ + n] = mfma16(ones, pb[k2], L[mp * NQ + n]);
          }
        }
      }
    }
    }
    __syncthreads();
    kt = nxt; nxt = nxt2; stg ^= 1;
  }
#pragma unroll
  for (int i = 0; i < NQ * NMAP; ++i) l[i] = L[i][0];
}

__device__ void item_diff(const Params& p, int layer, int b, int hd, int qt, unsigned char* smem) {
  u16* sK = (u16*)smem;
  u16* sVt = sK + 64 * 72;
  const int tid = otid(), lane = tid & 63, l15 = lane & 15, quad = lane >> 4;
  const int wave = __builtin_amdgcn_readfirstlane(tid >> 6);
  const int q0 = qt * 64;
  const int qlo = q0 + wave * 16;
  int tq[1];
  tq[0] = qlo + l15;
  const float slope2 = exp2f(-2.f * (float)(hd + 1)) * LOG2E;
  const unsigned selq[1] = {0xffffffffu};
  const float c1 = 0.17677669529663687f * LOG2E;
  const float lam = P_LAM[layer];
  const float lam_init = 0.8f - 0.6f * expf(-0.3f * (float)layer);
  const u16* hb = P_H + (size_t)b * SEQ * HS;
  const u16* vt = P_VT + ((size_t)b * VTC + hd * 64) * SEQ;
  bf16x8 qf[1][2];
#pragma unroll
  for (int ks = 0; ks < 2; ++ks)
    qf[0][ks] = *(const bf16x8*)(hb + (size_t)tq[0] * HS + C_QA + hd * 64 + ks * 32 + quad * 8);
  uint2 gpre[4];
#pragma unroll
  for (int dt = 0; dt < 4; ++dt)
    gpre[dt] = *(const uint2*)(hb + (size_t)tq[0] * HS + C_GA + hd * 64 + dt * 16 + quad * 4);
  f32x4 O[2][4];
  float l[2] = {0.f, 0.f};
#pragma unroll
  for (int i = 0; i < 2; ++i)
#pragma unroll
    for (int dt = 0; dt < 4; ++dt) O[i][dt] = f32x4{0.f, 0.f, 0.f, 0.f};
  flash_pass<false, 2, 1, 2>(hb + C_KA + hd * 64, HS, vt, SEQ, 0, (qt + 2) & ~1, 0u, qf, tq, qlo, qlo + 15, slope2,
                          0x7fffffff, selq, c1, O, l, sK, sVt);
  {
    const float inv1 = 1.f / l[0];
    const float inv2 = lam / l[1];
    f32x4 Of[4];
    float ss = 0.f;
#pragma unroll
    for (int dt = 0; dt < 4; ++dt) {
      Of[dt] = O[0][dt] * inv1 - O[1][dt] * inv2;
#pragma unroll
      for (int r = 0; r < 4; ++r) ss += Of[dt][r] * Of[dt][r];
    }
    ss = quad_sum(ss);
    float rstd = rsqrtf(ss * (1.f / 64.f) + 1e-6f) * (1.f - lam_init);
    const size_t tok = (size_t)b * SEQ + tq[0];
#pragma unroll
    for (int dt = 0; dt < 4; ++dt) {
      int d = dt * 16 + quad * 4;
      float4 sw = *(const float4*)(p.subln + layer * 64 + d);
      uint2 g2 = gpre[dt];
      float g0 = bf2f((u16)(g2.x & 0xffff)), g1 = bf2f((u16)(g2.x >> 16)), g2f = bf2f((u16)(g2.y & 0xffff)), g3 = bf2f((u16)(g2.y >> 16));
      float o0 = Of[dt][0] * rstd * sw.x * silu_f(g0);
      float o1 = Of[dt][1] * rstd * sw.y * silu_f(g1);
      float o2 = Of[dt][2] * rstd * sw.z * silu_f(g2f);
      float o3 = Of[dt][3] * rstd * sw.w * silu_f(g3);
      uint2 o; o.x = pack2(o0, o1); o.y = pack2(o2, o3);
      *(uint2*)(P_XN + tok * DM + hd * 64 + d) = o;
    }
  }
}

__device__ void item_swa(const Params& p, int layer, int b, int g, int qt, unsigned char* smem) {
  u16* sK = (u16*)smem;
  u16* sVt = sK + 64 * 72;
  const int tid = otid(), lane = tid & 63, l15 = lane & 15, quad = lane >> 4;
  const int wave = __builtin_amdgcn_readfirstlane(tid >> 6);
  const int q0 = qt * 64;
  const int hh = g * 2 + (wave >> 1);
  const int qlo = q0 + (wave & 1) * 32;
  int tq[2];
  tq[0] = qlo + l15; tq[1] = tq[0] + 16;
  const float slope2 = exp2f(-2.f * (float)(hh + 1)) * LOG2E;
  const unsigned selq[2] = {0xffffffffu, 0xffffffffu};
  const float c1 = 0.125f * LOG2E;
  const u16* hb = P_H + (size_t)b * SEQ * HS;
  const u16* vt = P_VT + ((size_t)b * VTC + 256 + g * 64) * SEQ;
  bf16x8 qf[2][2];
#pragma unroll
  for (int n = 0; n < 2; ++n)
#pragma unroll
    for (int ks = 0; ks < 2; ++ks)
      qf[n][ks] = *(const bf16x8*)(hb + (size_t)tq[n] * HS + C_QB + hh * 64 + ks * 32 + quad * 8);
  uint2 gpre[2][4];
#pragma unroll
  for (int n = 0; n < 2; ++n)
#pragma unroll
    for (int dt = 0; dt < 4; ++dt)
      gpre[n][dt] = *(const uint2*)(hb + (size_t)tq[n] * HS + C_GB + hh * 64 + dt * 16 + quad * 4);
  f32x4 O[2][4];
  float l[2] = {0.f, 0.f};
#pragma unroll
  for (int n = 0; n < 2; ++n)
#pragma unroll
    for (int dt = 0; dt < 4; ++dt) O[n][dt] = f32x4{0.f, 0.f, 0.f, 0.f};
  int ktb = qt - 2; if (ktb < 0) ktb = 0;
  int kte = qt + 1;
  if ((kte - ktb) & 1) { if (ktb > 0) --ktb; else ++kte; }
  flash_pass<false, 1, 2, 2>(hb + C_KB + g * 64, HS, vt, SEQ, ktb, kte, 0u, qf, tq, qlo, qlo + 31, slope2, 128, selq, c1,
                             O, l, sK, sVt);
  const float sink2 = p.sinks[layer * 4 + hh] * LOG2E;
#pragma unroll
  for (int n = 0; n < 2; ++n) {
    float lt = l[n] + fexp2(sink2);
    float inv = 1.f / lt;
    const size_t tok = (size_t)b * SEQ + tq[n];
#pragma unroll
    for (int dt = 0; dt < 4; ++dt) {
      int d = dt * 16 + quad * 4;
      uint2 g2 = gpre[n][dt];
      float g0 = bf2f((u16)(g2.x & 0xffff)), g1 = bf2f((u16)(g2.x >> 16)), g2f = bf2f((u16)(g2.y & 0xffff)), g3 = bf2f((u16)(g2.y >> 16));
      float o0 = O[n][dt][0] * inv * silu_f(g0);
      float o1 = O[n][dt][1] * inv * silu_f(g1);
      float o2 = O[n][dt][2] * inv * silu_f(g2f);
      float o3 = O[n][dt][3] * inv * silu_f(g3);
      uint2 o; o.x = pack2(o0, o1); o.y = pack2(o2, o3);
      *(uint2*)(P_XN + tok * DM + 256 + hh * 64 + d) = o;
    }
  }
}

__device__ void item_compress(const Params& p, int layer, int kv, int b, int g, int ct, unsigned char* smem) {
  float* sP = (float*)smem;
  u16* sH = (u16*)(smem + 4 * 16 * 132 * 4);
  const int tid = otid(), wave = tid >> 6, lane = tid & 63, l15 = lane & 15, quad = lane >> 4;
  const int c0 = ct * 16;
  const int c = c0 + l15;
  const bool cvalid = c < 127;
  const int col = (kv ? C_VC : C_KC) + g * 64;
  const float* pe = (kv ? p.pe_v : p.pe_k) + (size_t)layer * 32 * 64;
  const u16* w1t = (kv ? P_WV1_T : P_WK1_T) + (size_t)layer * 128 * 2048;
  const u16* w2t = (kv ? P_WV2_T : P_WK2_T) + (size_t)layer * 64 * 128;
  const u16* src = P_H + ((size_t)b * SEQ + (size_t)(cvalid ? 16 * c : 0)) * HS + col + quad * 8;
  const u16* wb = w1t + (size_t)l15 * 2048 + quad * 8;
  f32x4 acc[8];
#pragma unroll
  for (int j = 0; j < 8; ++j) acc[j] = f32x4{0.f, 0.f, 0.f, 0.f};
#pragma unroll 4
  for (int ii = 0; ii < 8; ++ii) {
    const int i = wave * 8 + ii;
#pragma unroll
    for (int ks = 0; ks < 2; ++ks) {
      uint4 raw = *(const uint4*)(src + (size_t)i * HS + ks * 32);
      const float* pp = pe + i * 64 + ks * 32 + quad * 8;
      float4 p0 = *(const float4*)pp, p1 = *(const float4*)(pp + 4);
      bf16x8 a = pack8(bf2f((u16)(raw.x & 0xffff)) + p0.x, bf2f((u16)(raw.x >> 16)) + p0.y,
                       bf2f((u16)(raw.y & 0xffff)) + p0.z, bf2f((u16)(raw.y >> 16)) + p0.w,
                       bf2f((u16)(raw.z & 0xffff)) + p1.x, bf2f((u16)(raw.z >> 16)) + p1.y,
                       bf2f((u16)(raw.w & 0xffff)) + p1.z, bf2f((u16)(raw.w >> 16)) + p1.w);
#pragma unroll
      for (int j = 0; j < 8; ++j) {
        bf16x8 bfr = *(const bf16x8*)(wb + (size_t)(j * 16) * 2048 + i * 64 + ks * 32);
        acc[j] = mfma16(a, bfr, acc[j]);
      }
    }
  }
  __syncthreads();
#pragma unroll
  for (int j = 0; j < 8; ++j)
#pragma unroll
    for (int r = 0; r < 4; ++r) sP[(wave * 16 + quad * 4 + r) * 132 + j * 16 + l15] = acc[j][r];
  __syncthreads();
#pragma unroll
  for (int e = 0; e < 8; ++e) {
    int idx = e * 256 + tid;
    int row = idx >> 7, cc = idx & 127;
    float v = ((sP[row * 132 + cc] + sP[(16 + row) * 132 + cc]) + sP[(32 + row) * 132 + cc]) + sP[(48 + row) * 132 + cc];
    v = silu_f(v);
    sH[row * 136 + cc] = (u16)(pack2(v, 0.f) & 0xffff);
  }
  __syncthreads();
  f32x4 a2 = f32x4{0.f, 0.f, 0.f, 0.f};
#pragma unroll
  for (int ks = 0; ks < 4; ++ks) {
    bf16x8 a = *(const bf16x8*)(sH + l15 * 136 + ks * 32 + quad * 8);
    bf16x8 bb = *(const bf16x8*)(w2t + (size_t)(wave * 16 + l15) * 128 + ks * 32 + quad * 8);
    a2 = mfma16(a, bb, a2);
  }
  const int d = wave * 16 + l15;
  const int cc = c0 + quad * 4;
  float v0 = a2[0], v1 = a2[1], v2 = a2[2], v3 = (cc + 3 < 127) ? a2[3] : 0.f;
  if (kv == 0) {
    u16* dst = P_KCMP + ((size_t)(b * 2 + g) * 128 + cc) * 64 + d;
    dst[0] = (u16)(pack2(v0, 0.f) & 0xffff);
    dst[64] = (u16)(pack2(v1, 0.f) & 0xffff);
    dst[128] = (u16)(pack2(v2, 0.f) & 0xffff);
    dst[192] = (u16)(pack2(v3, 0.f) & 0xffff);
  } else {
    uint2 o; o.x = pack2(v0, v1); o.y = pack2(v2, v3);
    *(uint2*)(P_VCMP_T + ((size_t)(b * 2 + g) * 64 + d) * 128 + cc) = o;
  }
}

__device__ void item_nsa(const Params& p, int layer, int b, int g, int qt, unsigned char* smem) {
  u16* sK = (u16*)smem;
  u16* sVt = sK + 64 * 72;
  u16* sK2 = (u16*)smem;
  u16* sV2 = sK2 + 128 * 72;
  float* sImp = (float*)(smem + SM_IMP_OFF);
  unsigned* sSel = (unsigned*)(smem + SM_MAIN);
  const int tid = otid(), lane = tid & 63, l15 = lane & 15, quad = lane >> 4;
  const int wave = __builtin_amdgcn_readfirstlane(tid >> 6);
  const int q0 = qt * 32;
  const int hh = g * 4 + wave;
  int tq[2];
  tq[0] = q0 + l15; tq[1] = tq[0] + 16;
  const float slope = exp2f(-(float)(hh + 1));
  float slope2[2] = {slope * LOG2E, slope * LOG2E};
  const float c1 = 0.125f * LOG2E;
  const u16* hb = P_H + (size_t)b * SEQ * HS;
  bf16x8 qf[2][2];
  float gate[2][3];
#pragma unroll
  for (int n = 0; n < 2; ++n) {
#pragma unroll
    for (int ks = 0; ks < 2; ++ks)
      qf[n][ks] = *(const bf16x8*)(hb + (size_t)tq[n] * HS + C_QC + hh * 64 + ks * 32 + quad * 8);
#pragma unroll
    for (int i = 0; i < 3; ++i) gate[n][i] = sigmoid_f(bf2f(hb[(size_t)tq[n] * HS + C_GL + hh * 3 + i]));
  }
  f32x4 Of[2][4];
  {
    const u16* kc = P_KCMP + (size_t)(b * 2 + g) * 128 * 64;
    const u16* vc = P_VCMP_T + (size_t)(b * 2 + g) * 64 * 128;
    __syncthreads();
#pragma unroll
    for (int c = tid; c < 1024; c += 256) {
      int key = c >> 3, kc8 = (c & 7) * 8;
      *(uint4*)(sK2 + key * 64 + (((c & 7) ^ ((key >> 1) & 7)) * 8)) = *(const uint4*)(kc + key * 64 + kc8);
    }
#pragma unroll
    for (int c = tid; c < 1024; c += 256) {
      int d = c >> 4, kc8 = (c & 15) * 8;
      *(uint4*)(sV2 + d * 136 + kc8) = *(const uint4*)(vc + d * 128 + kc8);
    }
    if (tid < 33) sSel[tid] = 0u;
    __syncthreads();
#pragma unroll
    for (int n = 0; n < 2; ++n) {
      f32x4 S[8];
#pragma unroll
      for (int mt = 0; mt < 8; ++mt) S[mt] = f32x4{0.f, 0.f, 0.f, 0.f};
#pragma unroll
      for (int ks = 0; ks < 2; ++ks)
#pragma unroll
        for (int mt = 0; mt < 8; ++mt) {
          bf16x8 a = *(const bf16x8*)(sK2 + (mt * 16 + l15) * 64 + (((ks * 4 + quad) ^ ((l15 >> 1) & 7)) * 8));
          S[mt] = mfma16(a, qf[n][ks], S[mt]);
        }
      float mx = -1e30f;
#pragma unroll
      for (int mt = 0; mt < 8; ++mt)
#pragma unroll
        for (int r = 0; r < 4; ++r) {
          int c = mt * 16 + quad * 4 + r;
          int dist = tq[n] - (16 * c + 31);
          bool valid = (dist >= 0) && (c < 127);
          float s = S[mt][r] * c1 - slope2[n] * (float)dist;
          s = valid ? s : -1e30f;
          S[mt][r] = s;
          mx = fmaxf(mx, s);
        }
      mx = quad_max(mx);
      float rs = 0.f;
#pragma unroll
      for (int mt = 0; mt < 8; ++mt)
#pragma unroll
        for (int r = 0; r < 4; ++r) {
          float s = S[mt][r];
          float pv = (s > -5e29f) ? fexp2(s - mx) : 0.f;
          S[mt][r] = pv;
          rs += pv;
        }
      rs = quad_sum(rs);
      float inv = (rs > 0.f) ? 1.f / rs : 0.f;
      float bprev = 0.f;
#pragma unroll
      for (int mt = 0; mt < 8; ++mt) {
        f32x4 pn = S[mt] * inv;
        S[mt] = pn;
        float av = pn[0] + pn[1] + pn[2] + 0.5f * pn[3];
        float bc = 0.5f * pn[3];
        float send = (quad == 3) ? bprev : bc;
        float recv = __shfl(send, (lane + 48) & 63);
        bprev = bc;
        sImp[(wave * 32 + n * 16 + l15) * 33 + mt * 4 + quad] = av + recv;
      }
      bf16x8 pb[4];
#pragma unroll
      for (int k2 = 0; k2 < 4; ++k2)
        pb[k2] = pack8(S[2 * k2][0], S[2 * k2][1], S[2 * k2][2], S[2 * k2][3],
                       S[2 * k2 + 1][0], S[2 * k2 + 1][1], S[2 * k2 + 1][2], S[2 * k2 + 1][3]);
      f32x4 Oc[4];
#pragma unroll
      for (int dt = 0; dt < 4; ++dt) Oc[dt] = f32x4{0.f, 0.f, 0.f, 0.f};
#pragma unroll
      for (int k2 = 0; k2 < 4; ++k2)
#pragma unroll
        for (int dt = 0; dt < 4; ++dt) {
          const u16* vp = sV2 + (dt * 16 + l15) * 136 + k2 * 32 + quad * 4;
          uint2 lo = *(const uint2*)vp;
          uint2 hi = *(const uint2*)(vp + 16);
          u32x4 u; u[0] = lo.x; u[1] = lo.y; u[2] = hi.x; u[3] = hi.y;
          bf16x8 a = __builtin_bit_cast(bf16x8, u);
          Oc[dt] = mfma16(a, pb[k2], Oc[dt]);
        }
#pragma unroll
      for (int dt = 0; dt < 4; ++dt) Of[n][dt] = Oc[dt] * gate[n][0];
    }
  }
  unsigned selq[2] = {0u, 0u};
  unsigned tilemask = 0u;
  const int kt_end = ((q0 + 31) >> 6) + 1;
  u16* sOf = (u16*)sImp + (wave * 32 + l15) * 72 + quad * 4;
  auto sel_hook = [&]() {
    __syncthreads();
  #pragma unroll 1
    for (int e = tid; e < 32 * 33; e += 256) {
      float v = ((sImp[e] + sImp[32 * 33 + e]) + sImp[2 * 32 * 33 + e]) + sImp[3 * 32 * 33 + e];
      sImp[e] = v;
    }
    __syncthreads();
    {
      const int q = tid >> 3, sub = tid & 7;
      const int cur = (q0 + q) >> 6;
      unsigned mask = 1u | (1u << cur);
      if (cur >= 1) mask |= (1u << (cur - 1));
      int nsel = __popc(mask);
      float cv[4];
  #pragma unroll
      for (int i = 0; i < 4; ++i) {
        int j = sub * 4 + i;
        bool cand = (j <= cur) && !((mask >> j) & 1u);
        cv[i] = cand ? sImp[q * 33 + j] : -1.f;
      }
  #pragma unroll 1
      for (int slot = 0; slot < 5; ++slot) {
        float bv = cv[0]; int bi = sub * 4;
  #pragma unroll
        for (int i = 1; i < 4; ++i) if (cv[i] > bv) { bv = cv[i]; bi = sub * 4 + i; }
  #pragma unroll
        for (int o = 1; o < 8; o <<= 1) {
          float ov = __shfl_xor(bv, o); int oi = __shfl_xor(bi, o);
          if (ov > bv || (ov == bv && oi < bi)) { bv = ov; bi = oi; }
        }
        if (nsel < 8 && bv >= 0.f) {
          mask |= (1u << bi); ++nsel;
  #pragma unroll
          for (int i = 0; i < 4; ++i) if (sub * 4 + i == bi) cv[i] = -1.f;
        }
      }
      if (sub == 0) { sSel[q] = mask; atomicOr(&sSel[32], mask); }
    }
    __syncthreads();

    selq[0] = sSel[l15]; selq[1] = sSel[16 + l15];
    tilemask = sSel[32];

  };
  {
    f32x4 O[2][4];
    float l[2] = {0.f, 0.f};
#pragma unroll
    for (int n = 0; n < 2; ++n)
#pragma unroll
      for (int dt = 0; dt < 4; ++dt) O[n][dt] = f32x4{0.f, 0.f, 0.f, 0.f};
    const u16* vt = P_VT + ((size_t)b * VTC + 512 + g * 64) * SEQ;
    int lo = q0 - 511; if (lo < 0) lo = 0;
    const unsigned allsel[2] = {0xffffffffu, 0xffffffffu};
    int wkb = lo >> 6, wke = kt_end;
    if ((wke - wkb) & 1) { if (wkb > 0) --wkb; else ++wke; }
    flash_pass<false, 1, 2, 2>(hb + C_KW + g * 64, HS, vt, SEQ, wkb, wke, 0u, qf, tq, q0, q0 + 31, slope2[0], 512, allsel, c1, O, l, sK, sVt, sel_hook);
    __syncthreads();
#pragma unroll
    for (int n = 0; n < 2; ++n) {
      float inv = gate[n][2] / l[n];
#pragma unroll
      for (int dt = 0; dt < 4; ++dt) {
        float a0 = Of[n][dt][0] + O[n][dt][0] * inv, a1 = Of[n][dt][1] + O[n][dt][1] * inv;
        float a2 = Of[n][dt][2] + O[n][dt][2] * inv, a3 = Of[n][dt][3] + O[n][dt][3] * inv;
        uint2 o; o.x = pack2(a0, a1); o.y = pack2(a2, a3);
        *(uint2*)(sOf + n * 16 * 72 + dt * 16) = o;
      }
    }
  }
  u32x4 gfin[4];
  {
    f32x4 O[2][4];
    float l[2] = {0.f, 0.f};
#pragma unroll
    for (int n = 0; n < 2; ++n)
#pragma unroll
      for (int dt = 0; dt < 4; ++dt) O[n][dt] = f32x4{0.f, 0.f, 0.f, 0.f};
    const u16* vt = P_VT + ((size_t)b * VTC + 384 + g * 64) * SEQ;
    flash_pass<true, 1, 2>(hb + C_KS + g * 64, HS, vt, SEQ, 0, kt_end, tilemask, qf, tq, q0, q0 + 31, slope2[0], 0x7fffffff, selq, c1, O, l, sK, sVt);
#pragma unroll
    for (int i = 0; i < 4; ++i) {
      const int c = tid + i * 256;
      const int row = c >> 3, ch = c & 7;
      gfin[i] = *(const u32x4*)(P_H + ((size_t)b * SEQ + q0 + (row & 31)) * HS + C_GC + (g * 4 + (row >> 5)) * 64 + ch * 8);
    }
#pragma unroll
    for (int n = 0; n < 2; ++n) {
      float inv = gate[n][1] / l[n];
#pragma unroll
      for (int dt = 0; dt < 4; ++dt) {
        uint2 v = *(const uint2*)(sOf + n * 16 * 72 + dt * 16);
        float a0 = bf2f((u16)(v.x & 0xffff)) + O[n][dt][0] * inv, a1 = bf2f((u16)(v.x >> 16)) + O[n][dt][1] * inv;
        float a2 = bf2f((u16)(v.y & 0xffff)) + O[n][dt][2] * inv, a3 = bf2f((u16)(v.y >> 16)) + O[n][dt][3] * inv;
        uint2 o; o.x = pack2(a0, a1); o.y = pack2(a2, a3);
        *(uint2*)(sOf + n * 16 * 72 + dt * 16) = o;
      }
    }
  }
  __syncthreads();
  {
    const u16* sRow = (const u16*)sImp;
#pragma unroll
    for (int i = 0; i < 4; ++i) {
      const int c = tid + i * 256;
      const int row = c >> 3, ch = c & 7;
      const size_t tok = (size_t)b * SEQ + q0 + (row & 31);
      const int hcol = (g * 4 + (row >> 5)) * 64 + ch * 8;
      u32x4 v = *(const u32x4*)(sRow + row * 72 + ch * 8);
      u32x4 gt = gfin[i];
      u32x4 o;
#pragma unroll
      for (int k = 0; k < 4; ++k) {
        float x0 = bf2f((u16)(v[k] & 0xffff)) * silu_f(bf2f((u16)(gt[k] & 0xffff)));
        float x1 = bf2f((u16)(v[k] >> 16)) * silu_f(bf2f((u16)(gt[k] >> 16)));
        o[k] = pack2(x0, x1);
      }
      *(u32x4*)(P_XN + tok * DM + 512 + hcol) = o;
    }
  }
}

__device__ void phase_x(const Params& p, int layer, unsigned char* smem) {
  constexpr int NA = 8 * 4 * 32, NC = 2 * 8 * 2 * 8, NBI = 8 * 2 * 32;
  const int G = gridDim.x;
  for (int i = blockIdx.x; i < NA / 2; i += G) {
#pragma unroll 1
    for (int h = 0; h < 2; ++h) {
      int it = h ? (NA - 1 - i) : i;
      int qt = 31 - (it >> 5); int r = it & 31; int b = r >> 2, hd = r & 3;
      item_diff(p, layer, b, hd, qt, smem);
    }
  }
  for (int i = blockIdx.x; i < NC; i += G) {
    int t = i; int ct = t & 7; t >>= 3; int g = t & 1; t >>= 1; int b = t & 7; int kv = t >> 3;
    item_compress(p, layer, kv, b, g, ct, smem);
  }
  {
    const int nfree = G - NC;
    int i0, step;
    if (nfree >= 64) { i0 = (int)blockIdx.x - NC; step = nfree; if (i0 < 0) i0 = NBI; }
    else { i0 = blockIdx.x; step = G; }
    for (int i = i0; i < NBI; i += step) {
      int t = i; int qt = t & 31; t >>= 5; int g = t & 1; int b = t >> 1;
      item_swa(p, layer, b, g, qt, smem);
    }
  }
}

__device__ void phase_y(const Params& p, int layer, unsigned char* smem) {
  constexpr int NI = 8 * 2 * 64;
  const int G = gridDim.x;
  for (int i = blockIdx.x; i < NI / 2; i += G) {
#pragma unroll 1
    for (int h = 0; h < 2; ++h) {
      int it = h ? (NI - 1 - i) : i;
      int qt = 63 - (it >> 4); int r = it & 15; int b = r >> 1, g = r & 1;
      item_nsa(p, layer, b, g, qt, smem);
    }
  }
}

__device__ void run_phase(const Params& p, int ph, unsigned char* smem) {
  if (ph == 0) { phase_setup(p, smem); phase_rmsnorm<0>(p.x, p.norm_w, P_XN, nullptr); return; }
  if (ph == NPH - 1) { phase_rmsnorm<1>(p.out, p.final_norm, nullptr, p.out); return; }
  const int layer = (ph - 1) / 5, sub = (ph - 1) % 5;
  switch (sub) {
    case 0: phase_rmsnorm<0>(p.out, p.norm_w + layer * DM, P_XN, nullptr); break;
    case 1: phase_inproj(p, layer, smem); break;
    case 2: phase_x(p, layer, smem); break;
    case 3: phase_y(p, layer, smem); break;
    default: phase_outproj(p, layer, smem); break;
  }
}

#define XB_TMO      128
#define XB_XCNT(j)  (256  + 64 * (j))
#define XB_XSUB(j)  (1280 + 64 * (j))
#define XB_XGEN(j)  (2304 + 64 * (j))
#define XB_TOP      3328
#define XB_TOPGEN   3392
#define XCD_BAR_WORDS 3456
#define XB_SPIN_CAP (1u << 18)
#define LAS __attribute__((address_space(3)))

__device__ __forceinline__ unsigned xb_ld(unsigned* p)              { return __hip_atomic_load(p, __ATOMIC_RELAXED, __HIP_MEMORY_SCOPE_AGENT); }
__device__ __forceinline__ unsigned xb_add(unsigned* p, unsigned v) { return __hip_atomic_fetch_add(p, v, __ATOMIC_RELAXED, __HIP_MEMORY_SCOPE_AGENT); }
__device__ __forceinline__ unsigned xb_xcc_id() { return (unsigned)__builtin_amdgcn_s_getreg((3 << 11) | 20) & 0xFu; }
#define XB_SPIN(cond, bar) do { unsigned _sp = 0; while (cond) { __builtin_amdgcn_s_sleep(1); \
    if ((++_sp & 255u) == 0u) { if (xb_ld(&(bar)[XB_TMO])) break; if (_sp > XB_SPIN_CAP) { atomicAdd(&(bar)[XB_TMO], 1u); break; } } } } while (0)

struct XcdBarrier {
    unsigned* bar; unsigned x;
    volatile LAS unsigned* st;
};

__device__ __forceinline__ XcdBarrier xcd_barrier_post(unsigned* bar, volatile LAS unsigned* st) {
    XcdBarrier b; b.bar = bar; b.x = xb_xcc_id(); b.st = st;
    if (threadIdx.x == 0) (void)xb_add(&bar[XB_XCNT(b.x)], 1u);
    return b;
}
__device__ __forceinline__ void xcd_barrier_complete(unsigned* bar, unsigned x, unsigned& nloc, unsigned& nx) {
    const unsigned G = gridDim.x * gridDim.y * gridDim.z;
    unsigned sum, cnt, mine, sp = 0u;
    for (;;) {
        sum = 0u; cnt = 0u; mine = 0u;
#pragma unroll
        for (unsigned j = 0; j < 16; ++j) { const unsigned c = xb_ld(&bar[XB_XCNT(j)]); sum += c; cnt += (c > 0u) ? 1u : 0u; mine = (j == x) ? c : mine; }
        if (sum == G) break;
        __builtin_amdgcn_s_sleep(1);
        if ((++sp & 255u) == 0u) { if (xb_ld(&bar[XB_TMO])) break; if (sp > XB_SPIN_CAP) { atomicAdd(&bar[XB_TMO], 1u); break; } }
    }
    nloc = mine > 0u ? mine : 1u; nx = cnt > 0u ? cnt : 1u;
}

__device__ __forceinline__ void xcd_barrier(const XcdBarrier& b) {
    asm volatile("s_waitcnt vmcnt(0)" ::: "memory");
    __syncthreads();
    if (threadIdx.x == 0) {
        unsigned* bar = b.bar;
        __builtin_amdgcn_s_waitcnt(0);
        unsigned nloc = b.st[0], nx = b.st[1];
        if (nloc == 0u) { xcd_barrier_complete(bar, b.x, nloc, nx); b.st[0] = nloc; b.st[1] = nx; }
        const unsigned old = xb_add(&bar[XB_XSUB(b.x)], 1u);
        const unsigned gen = old / nloc;
        if (old + 1u == (gen + 1u) * nloc) {
            __builtin_amdgcn_fence(__ATOMIC_RELEASE, "agent");
            asm volatile("s_waitcnt vmcnt(0)" ::: "memory");
            const unsigned og = xb_add(&bar[XB_TOP], 1u);
            const unsigned tg = og / nx;
            if (og + 1u == (tg + 1u) * nx) xb_add(&bar[XB_TOPGEN], 1u);
            else XB_SPIN(xb_ld(&bar[XB_TOPGEN]) == tg, bar);
            __builtin_amdgcn_fence(__ATOMIC_ACQUIRE, "agent");
            xb_add(&bar[XB_XGEN(b.x)], 1u);
            asm volatile("s_waitcnt vmcnt(0)" ::: "memory");
        } else {
            XB_SPIN(xb_ld(&bar[XB_XGEN(b.x)]) == gen, bar);
            __builtin_amdgcn_fence(__ATOMIC_ACQUIRE, "agent");
            asm volatile("s_waitcnt vmcnt(0)" ::: "memory");
        }
    }
    __syncthreads();
}


__global__ void __launch_bounds__(256, 2) hybrid_megakernel(Params p, int ph_lo, int ph_hi) {
  __shared__ __attribute__((aligned(16))) unsigned char smem[SM_TOTAL];
  __shared__ uint4 xb_words;
  if (threadIdx.x == 0) xb_words = make_uint4(0u, 0u, 0u, 0u);
  __syncthreads();
  XcdBarrier xb = xcd_barrier_post((unsigned*)P_CTR, (volatile LAS unsigned*)&xb_words);
  for (int ph = ph_lo; ph < ph_hi; ++ph) {
    if (ph == 1) continue;
    run_phase(p, ph, smem);
    if (ph + 1 < ph_hi) {
      if (ph_hi > 1000) cg::this_grid().sync();
      xcd_barrier(xb);
    }
  }
}

static inline size_t align_up(size_t v) { return (v + 255) & ~(size_t)255; }

extern "C" void kernel_launch(void* const* d_in, const int* in_sizes, int n_in, void* d_out, int out_size,
                              void* d_ws, size_t ws_size, hipStream_t stream) {
  Params p{};
  p.x = (const float*)d_in[0]; p.norm_w = (const float*)d_in[1]; p.w_in = (const float*)d_in[2];
  p.w_out = (const float*)d_in[3]; p.lq1 = (const float*)d_in[4]; p.lk1 = (const float*)d_in[5];
  p.lq2 = (const float*)d_in[6]; p.lk2 = (const float*)d_in[7]; p.subln = (const float*)d_in[8];
  p.sinks = (const float*)d_in[9]; p.pe_k = (const float*)d_in[10]; p.pe_v = (const float*)d_in[11];
  p.wk1 = (const float*)d_in[12]; p.wk2 = (const float*)d_in[13]; p.wv1 = (const float*)d_in[14];
  p.wv2 = (const float*)d_in[15]; p.final_norm = (const float*)d_in[16];
  p.out = (float*)d_out;
  p.ws = (unsigned char*)d_ws;
  if (WS_NEED > ws_size) fprintf(stderr, "workspace too small: need %zu have %zu\n", (size_t)WS_NEED, ws_size);
  (void)hipMemsetAsync(p.ws + OFF_CTR, 0, 16384, stream);
  static int grid_blocks = 0;
  if (!grid_blocks) {
    int dev = 0, cus = 0, per_cu = 0;
    hipGetDevice(&dev);
    hipDeviceGetAttribute(&cus, hipDeviceAttributeMultiprocessorCount, dev);
    hipOccupancyMaxActiveBlocksPerMultiprocessor(&per_cu, hybrid_megakernel, 256, 0);
    if (per_cu > 2) per_cu = 2;
    if (per_cu < 1) per_cu = 1;
    grid_blocks = (cus * per_cu) & ~15;
  }
#if MULTI_LAUNCH
  for (int ph = 0; ph < NPH; ++ph) {
    if (ph == 1) continue;
    int lo = ph, hi = ph + 1;
    hipLaunchKernelGGL(hybrid_megakernel, dim3(grid_blocks), dim3(256), 0, stream, p, lo, hi);
  }
#else
  int lo = 0, hi = NPH;
  void* args[] = {&p, &lo, &hi};
  hipError_t e = hipLaunchCooperativeKernel((void*)hybrid_megakernel, dim3(grid_blocks), dim3(256), args, 0, stream);
  if (e != hipSuccess) fprintf(stderr, "cooperative launch failed: %s (grid %d)\n", hipGetErrorString(e), grid_blocks);
#endif
}
```
